# Optimizing an MI355X kernel written in HIP

```python
import jax, jax.numpy as jnp
from jax import lax
import numpy as np

D_MODEL = 1024
BATCH = 4
SEQ = 8192
DEPTH = 1

CHUNK = 64
Q_BLOCK = 128
NORM_EPS = 1e-6
LRU_WIDTH = D_MODEL
LRU_BLOCKS = 8
LRU_BLOCK_DIM = LRU_WIDTH // LRU_BLOCKS
CONV_WIDTH = 4
LRU_C = 8.0
HEAD_DIM = 128
N_HEADS = D_MODEL // HEAD_DIM
N_KV_HEADS = max(1, N_HEADS // 4)
IDX_HEADS = 8
IDX_DIM = 64
MAX_TOPK = 256
ROPE_THETA = 500000.0
ROT_FRACTION = 4
N_GROUPS = 4
EXPERTS_PER_GROUP = 8
N_EXPERTS = N_GROUPS * EXPERTS_PER_GROUP
TOP_K_EXPERTS = 2
EXPERT_FF = D_MODEL // 2
MOE_BLOCK = 256
COL_SIZES = (LRU_WIDTH, LRU_WIDTH, N_HEADS * HEAD_DIM, N_KV_HEADS * HEAD_DIM, N_KV_HEADS * HEAD_DIM,
             IDX_HEADS * IDX_DIM, IDX_DIM, IDX_HEADS, 2 * D_MODEL)
IN_COLS = 2 * LRU_WIDTH + (N_HEADS + 2 * N_KV_HEADS) * HEAD_DIM + IDX_HEADS * IDX_DIM + IDX_DIM + IDX_HEADS + 2 * D_MODEL

kernel_name = "hybrid_rglru_dsa_hiermoe_block"


def rmsnorm(x, g):
    xf = x.astype(jnp.float32)
    y = xf * lax.rsqrt(jnp.mean(xf * xf, axis=-1, keepdims=True) + NORM_EPS)
    return (y * g.astype(jnp.float32)).astype(x.dtype)


def split_columns(proj):
    offsets = np.cumsum((0,) + COL_SIZES)
    return tuple(proj[..., int(offsets[i]):int(offsets[i + 1])] for i in range(len(COL_SIZES)))


def rope_tables(positions, rot_dim, dtype):
    inv_freq = ROPE_THETA ** (-jnp.arange(0, rot_dim, 2, dtype=jnp.float32) / rot_dim)
    ang = positions.astype(jnp.float32)[..., None] * inv_freq
    return jnp.cos(ang)[:, :, None, :].astype(dtype), jnp.sin(ang)[:, :, None, :].astype(dtype)


def partial_rope(x, cos, sin):
    half = cos.shape[-1]
    x1, x2, rest = x[..., :half], x[..., half:2 * half], x[..., 2 * half:]
    return jnp.concatenate([x1 * cos - x2 * sin, x2 * cos + x1 * sin, rest], axis=-1)


def causal_depthwise_conv(x, w, b):
    S = x.shape[1]
    xp = jnp.pad(x, ((0, 0), (CONV_WIDTH - 1, 0), (0, 0)))
    y = b
    for k in range(CONV_WIDTH):
        y = y + xp[:, k:k + S] * w[k]
    return y


def rg_lru(x, w_r, b_r, w_i, b_i, a_param):
    B, S, W = x.shape
    xb = x.reshape(B, S, LRU_BLOCKS, LRU_BLOCK_DIM)
    r = jax.nn.sigmoid(jnp.einsum('bsnc,ncd->bsnd', xb, w_r) + b_r).reshape(B, S, W)
    i = jax.nn.sigmoid(jnp.einsum('bsnc,ncd->bsnd', xb, w_i) + b_i).reshape(B, S, W)
    log_a = -LRU_C * r.astype(jnp.float32) * jax.nn.softplus(-a_param.astype(jnp.float32))
    a = jnp.exp(log_a)
    u = jnp.sqrt(-jnp.expm1(2.0 * log_a)) * (i * x).astype(jnp.float32)

    def combine(left, right):
        a1, b1 = left
        a2, b2 = right
        return a1 * a2, a2 * b1 + b2

    _, h = lax.associative_scan(combine, (a, u), axis=1)
    return h.astype(x.dtype)


def dsa_attention(q, k, v, q_idx, k_idx, w_idx):
    B, S = q.shape[:2]
    topk = min(MAX_TOPK, S // 4)
    n_blocks = S // Q_BLOCK
    key_chunk = jnp.arange(S) // CHUNK
    k_idx32 = k_idx.astype(jnp.float32)
    gather = jax.vmap(lambda t, ix: t[ix])

    def to_blocks(t):
        return t.reshape((B, n_blocks, Q_BLOCK) + t.shape[2:]).swapaxes(0, 1)

    def one_block(args):
        qb, qib, wb, blk = args
        qpos = blk * Q_BLOCK + jnp.arange(Q_BLOCK)
        rel = jax.nn.relu(jnp.einsum('bthd,bsd->bths', qib.astype(jnp.float32), k_idx32))
        score = jnp.einsum('bth,bths->bts', wb.astype(jnp.float32), rel)
        admissible = key_chunk[None, :] <= (qpos // CHUNK)[:, None]
        score = jnp.where(admissible[None], score, -jnp.inf)
        top_val, top_idx = lax.top_k(score, topk)
        valid = jnp.isfinite(top_val)
        k_sel = gather(k, top_idx)
        v_sel = gather(v, top_idx)
        qg = qb.reshape(B, Q_BLOCK, N_KV_HEADS, N_HEADS // N_KV_HEADS, HEAD_DIM)
        s = jnp.einsum('btjgd,btnjd->btjgn', qg, k_sel).astype(jnp.float32) * (HEAD_DIM ** -0.5)
        s = jnp.where(valid[:, :, None, None, :], s, -1e30)
        p = jax.nn.softmax(s, axis=-1).astype(v.dtype)
        o = jnp.einsum('btjgn,btnjd->btjgd', p, v_sel)
        return o.reshape(B, Q_BLOCK, N_HEADS * HEAD_DIM)

    out = lax.map(one_block, (to_blocks(q), to_blocks(q_idx), to_blocks(w_idx), jnp.arange(n_blocks)))
    return out.swapaxes(0, 1).reshape(B, S, N_HEADS * HEAD_DIM)


def hierarchical_moe(h, w_grp, b_grp, w_exp, b_exp, w13, w2):
    B, S, D = h.shape
    N = B * S
    hf = h.reshape(N, D)
    grp_logits = (hf @ w_grp).astype(jnp.float32) + b_grp
    g_star = jnp.argmax(grp_logits, axis=-1)
    p_grp = jnp.take_along_axis(jax.nn.softmax(grp_logits, axis=-1), g_star[:, None], axis=-1)
    exp_logits = ((hf @ w_exp).astype(jnp.float32) + b_exp).reshape(N, N_GROUPS, EXPERTS_PER_GROUP)
    in_grp = jnp.take_along_axis(exp_logits, g_star[:, None, None], axis=1)[:, 0]
    top_val, top_j = lax.top_k(in_grp, TOP_K_EXPERTS)
    gate = (p_grp * jax.nn.softmax(top_val, axis=-1)).reshape(-1)
    expert_id = (g_star[:, None] * EXPERTS_PER_GROUP + top_j).reshape(-1).astype(jnp.int32)
    token_id = jnp.repeat(jnp.arange(N, dtype=jnp.int32), TOP_K_EXPERTS)
    n_assign = N * TOP_K_EXPERTS
    order = jnp.argsort(expert_id)
    sorted_e, sorted_tok, sorted_gate = expert_id[order], token_id[order], gate[order]
    counts = jnp.bincount(expert_id, length=N_EXPERTS)
    starts = jnp.cumsum(counts) - counts
    pad_counts = (counts + MOE_BLOCK - 1) // MOE_BLOCK * MOE_BLOCK
    pad_ends = jnp.cumsum(pad_counts)
    pad_starts = pad_ends - pad_counts
    dest = pad_starts[sorted_e] + jnp.arange(n_assign, dtype=jnp.int32) - starts[sorted_e]
    n_slots = (-(-n_assign // MOE_BLOCK) + N_EXPERTS) * MOE_BLOCK
    n_blocks = n_slots // MOE_BLOCK
    slot_tok = jnp.full((n_slots,), N, dtype=jnp.int32).at[dest].set(sorted_tok)
    slot_gate = jnp.zeros((n_slots,), jnp.float32).at[dest].set(sorted_gate)
    block_e = jnp.minimum(jnp.searchsorted(pad_ends, jnp.arange(n_blocks) * MOE_BLOCK, side='right'),
                          N_EXPERTS - 1)
    h_pad = jnp.concatenate([hf, jnp.zeros((1, D), hf.dtype)], axis=0)
    xb = h_pad[slot_tok].reshape(n_blocks, MOE_BLOCK, D)

    def expert_block(args):
        xblk, e = args
        gu = xblk @ w13[e]
        g, u = jnp.split(gu, 2, axis=-1)
        return (jax.nn.silu(g) * u) @ w2[e]

    y = lax.map(expert_block, (xb, block_e)).reshape(n_slots, D)
    y = y * slot_gate[:, None].astype(y.dtype)
    return jax.ops.segment_sum(y, slot_tok, num_segments=N + 1)[:N].reshape(B, S, D)


def hybrid_layer(x, cos, sin, cos_i, sin_i, norm1_g, w_in, conv_w, conv_b, lru_w_r, lru_b_r, lru_w_i,
                 lru_b_i, lru_a_param, q_norm_g, k_norm_g, idx_k_norm_g, w_lru_out, w_attn_out, w_o,
                 norm2_g, w_grp, b_grp, w_exp, b_exp, w13, w2):
    B, S, _ = x.shape
    h = rmsnorm(x, norm1_g)
    lru_x, lru_gate, q, k, v, q_idx, k_idx, w_idx, merge = split_columns(h @ w_in)
    xa = causal_depthwise_conv(lru_x, conv_w, conv_b)
    ya = rg_lru(xa, lru_w_r, lru_b_r, lru_w_i, lru_b_i, lru_a_param) * jax.nn.gelu(lru_gate)
    q = partial_rope(rmsnorm(q.reshape(B, S, N_HEADS, HEAD_DIM), q_norm_g), cos, sin)
    k = partial_rope(rmsnorm(k.reshape(B, S, N_KV_HEADS, HEAD_DIM), k_norm_g), cos, sin)
    v = v.reshape(B, S, N_KV_HEADS, HEAD_DIM)
    q_idx = partial_rope(q_idx.reshape(B, S, IDX_HEADS, IDX_DIM), cos_i, sin_i)
    k_idx = partial_rope(rmsnorm(k_idx, idx_k_norm_g)[:, :, None, :], cos_i, sin_i)[:, :, 0]
    w_idx = w_idx * ((IDX_HEADS ** -0.5) * (IDX_DIM ** -0.5))
    yb = dsa_attention(q, k, v, q_idx, k_idx, w_idx)
    gate_a, gate_b = jnp.split(jax.nn.sigmoid(merge), 2, axis=-1)
    mixed = gate_a * (ya @ w_lru_out) + gate_b * (yb @ w_attn_out)
    x = x + mixed @ w_o
    return x + hierarchical_moe(rmsnorm(x, norm2_g), w_grp, b_grp, w_exp, b_exp, w13, w2)


def setup_inputs(seed: int = 0) -> dict:
    key = jax.random.key(seed)
    ks = jax.random.split(key, 26)
    f32 = jnp.float32
    nrm = lambda k, shape, scale: jax.random.normal(k, shape, f32) * scale
    u = jax.random.uniform(ks[9], (DEPTH, LRU_WIDTH), f32, minval=0.9, maxval=0.999)
    a0 = u ** (1.0 / LRU_C)
    offsets = jax.random.randint(ks[1], (BATCH, 1), 0, 4096, dtype=jnp.int32)
    return {
        "x": nrm(ks[0], (BATCH, SEQ, D_MODEL), 1.0),
        "positions": offsets + jnp.arange(SEQ, dtype=jnp.int32)[None, :],
        "norm1_g": 1.0 + nrm(ks[2], (DEPTH, D_MODEL), 0.02),
        "w_in": nrm(ks[3], (DEPTH, D_MODEL, IN_COLS), D_MODEL ** -0.5),
        "conv_w": nrm(ks[4], (DEPTH, CONV_WIDTH, LRU_WIDTH), CONV_WIDTH ** -0.5),
        "conv_b": nrm(ks[5], (DEPTH, LRU_WIDTH), 0.01),
        "lru_w_r": nrm(ks[6], (DEPTH, LRU_BLOCKS, LRU_BLOCK_DIM, LRU_BLOCK_DIM), LRU_BLOCK_DIM ** -0.5),
        "lru_b_r": nrm(ks[7], (DEPTH, LRU_BLOCKS, LRU_BLOCK_DIM), 0.01),
        "lru_w_i": nrm(ks[8], (DEPTH, LRU_BLOCKS, LRU_BLOCK_DIM, LRU_BLOCK_DIM), LRU_BLOCK_DIM ** -0.5),
        "lru_b_i": nrm(ks[10], (DEPTH, LRU_BLOCKS, LRU_BLOCK_DIM), 0.01),
        "lru_a_param": jnp.log(a0) - jnp.log1p(-a0),
        "q_norm_g": 1.0 + nrm(ks[11], (DEPTH, HEAD_DIM), 0.02),
        "k_norm_g": 1.0 + nrm(ks[12], (DEPTH, HEAD_DIM), 0.02),
        "idx_k_norm_g": 1.0 + nrm(ks[13], (DEPTH, IDX_DIM), 0.02),
        "w_lru_out": nrm(ks[14], (DEPTH, LRU_WIDTH, D_MODEL), LRU_WIDTH ** -0.5),
        "w_attn_out": nrm(ks[15], (DEPTH, N_HEADS * HEAD_DIM, D_MODEL), (N_HEADS * HEAD_DIM) ** -0.5),
        "w_o": nrm(ks[16], (DEPTH, D_MODEL, D_MODEL), D_MODEL ** -0.5),
        "norm2_g": 1.0 + nrm(ks[17], (DEPTH, D_MODEL), 0.02),
        "w_grp": nrm(ks[18], (DEPTH, D_MODEL, N_GROUPS), D_MODEL ** -0.5),
        "b_grp": nrm(ks[19], (DEPTH, N_GROUPS), 0.01),
        "w_exp": nrm(ks[20], (DEPTH, D_MODEL, N_EXPERTS), D_MODEL ** -0.5),
        "b_exp": nrm(ks[21], (DEPTH, N_EXPERTS), 0.01),
        "w13": nrm(ks[22], (DEPTH, N_EXPERTS, D_MODEL, 2 * EXPERT_FF), D_MODEL ** -0.5),
        "w2": nrm(ks[23], (DEPTH, N_EXPERTS, EXPERT_FF, D_MODEL), EXPERT_FF ** -0.5),
    }


def reference(x, positions, norm1_g, w_in, conv_w, conv_b, lru_w_r, lru_b_r, lru_w_i, lru_b_i,
              lru_a_param, q_norm_g, k_norm_g, idx_k_norm_g, w_lru_out, w_attn_out, w_o, norm2_g,
              w_grp, b_grp, w_exp, b_exp, w13, w2):
    cos, sin = rope_tables(positions, HEAD_DIM // ROT_FRACTION, x.dtype)
    cos_i, sin_i = rope_tables(positions, IDX_DIM // ROT_FRACTION, x.dtype)
    for l in range(DEPTH):
        x = hybrid_layer(x, cos, sin, cos_i, sin_i, norm1_g[l], w_in[l], conv_w[l], conv_b[l],
                         lru_w_r[l], lru_b_r[l], lru_w_i[l], lru_b_i[l], lru_a_param[l], q_norm_g[l],
                         k_norm_g[l], idx_k_norm_g[l], w_lru_out[l], w_attn_out[l], w_o[l], norm2_g[l],
                         w_grp[l], b_grp[l], w_exp[l], b_exp[l], w13[l], w2[l])
    return x
```

```cpp
#include <hip/hip_runtime.h>
#include <cstdio>
#include <cstdint>

#define LAS __attribute__((address_space(3)))
#define GAS __attribute__((address_space(1)))
typedef unsigned short bf16_t;
typedef short bf16x8 __attribute__((ext_vector_type(8)));
typedef float f32x4 __attribute__((ext_vector_type(4)));
typedef float f32x2 __attribute__((ext_vector_type(2)));
typedef float f32x16 __attribute__((ext_vector_type(16)));
typedef unsigned u32x4 __attribute__((ext_vector_type(4)));
typedef unsigned u32x2 __attribute__((ext_vector_type(2)));

constexpr int DM = 1024, NB = 4, SEQ = 8192, NTOK = NB * SEQ;
constexpr int NH = 8, HD = 128, NKV = 2, KVW = NKV * HD;
constexpr int IH = 8, IDIM = 64, TOPK = 256, CHUNK = 64;
constexpr int NEXP = 32, EPG = 8, NGRP = 4, EFF = 512;
constexpr int IN_COLS = 6216, NP = 6400;
constexpr int NSLOT = (NTOK * 2 / 256 + NEXP) * 256;
constexpr float NORM_EPS = 1e-6f;

constexpr size_t MiB = 1u << 20;
constexpr size_t WS_CTL = 0, CTL_BYTES = 1 * MiB;
constexpr size_t WS_WG = 1 * MiB;
constexpr size_t WS_WR = 2 * MiB;
constexpr size_t WS_WIN = 4 * MiB;
constexpr size_t WS_WA = 17 * MiB, WS_WB = 19 * MiB, WS_WO = 21 * MiB;
constexpr size_t WS_W13 = 23 * MiB;
constexpr size_t WS_W2 = 87 * MiB;
constexpr size_t WS_ROPE = 119 * MiB;
constexpr size_t WS_WIDX = 125 * MiB;
constexpr size_t WS_KIDX = 126 * MiB;
constexpr size_t WS_LSUM = 130 * MiB;
constexpr size_t WS_TOKE = 134 * MiB;
constexpr size_t WS_GATEE = 138 * MiB;
constexpr size_t WS_TINFO = 142 * MiB;
constexpr size_t WS_XN = 144 * MiB;
constexpr size_t WS_Q = 208 * MiB;
constexpr size_t WS_K = 272 * MiB, WS_V = 288 * MiB;
constexpr size_t WS_QIDX = 304 * MiB;
constexpr size_t WS_MISC = 336 * MiB;
constexpr size_t WS_LRUX = 352 * MiB;
constexpr size_t WS_GATE = 416 * MiB;
constexpr size_t WS_Y = 144 * MiB;
constexpr size_t WS_ACT = 416 * MiB;
constexpr size_t WS_LIST = 488 * MiB;
constexpr size_t WS_V8 = 480 * MiB;
constexpr size_t WS_K8 = 504 * MiB;
constexpr size_t WS_RSTDE = 119 * MiB;
constexpr size_t WS_XMID = 288 * MiB;
constexpr size_t WS_END = 512 * MiB;
static_assert(WS_ACT + (size_t)NSLOT * EFF * 2 <= WS_END && WS_Y + (size_t)NSLOT * DM * 2 <= WS_V, "ws map");

constexpr int CW_TMO = 0;
constexpr int CW_BAR = 4096;
constexpr int CW_ECNT = 16384;

#define LDS_WAIT() asm volatile("s_waitcnt lgkmcnt(0)" ::: "memory")
#define VM_WAIT() asm volatile("s_waitcnt vmcnt(0)" ::: "memory")
#define RLX_AGENT __ATOMIC_RELAXED, __HIP_MEMORY_SCOPE_AGENT
__device__ __forceinline__ unsigned f2bf(float f) { unsigned u = __builtin_bit_cast(unsigned, f); return (u + 0x7fffu + ((u >> 16) & 1u)) >> 16; }
__device__ __forceinline__ unsigned pk2(float lo, float hi) { return f2bf(lo) | (f2bf(hi) << 16); }
__device__ __forceinline__ float bf2f(unsigned short b) { return __builtin_bit_cast(float, (unsigned)b << 16); }
__device__ __forceinline__ float bflo(unsigned w) { return __builtin_bit_cast(float, w << 16); }
__device__ __forceinline__ float bfhi(unsigned w) { return __builtin_bit_cast(float, w & 0xffff0000u); }
__device__ __forceinline__ unsigned cvt_pk_bf16(float lo, float hi) { unsigned r; asm volatile("v_cvt_pk_bf16_f32 %0, %1, %2" : "=v"(r) : "v"(lo), "v"(hi)); return r; }
__device__ __forceinline__ float fast_exp(float x) { return __builtin_amdgcn_exp2f(x * 1.4426950408889634f); }
__device__ __forceinline__ float fast_rcp(float x) { return __builtin_amdgcn_rcpf(x); }
__device__ __forceinline__ float sigmoidf_(float x) { return fast_rcp(1.0f + fast_exp(-x)); }
__device__ __forceinline__ float gelu_tanh(float x) {
    const float z = 0.7978845608028654f * (x + 0.044715f * x * x * x);
    return x * sigmoidf_(2.0f * z);
}
__device__ __forceinline__ float wave_sum(float v) {
#pragma unroll
    for (int o = 1; o < 64; o <<= 1) v += __shfl_xor(v, o);
    return v;
}

namespace pg8 {
constexpr int BM = 256, BK = 64, HALF = 128, HTB = HALF * BK * 2, STAGE_BYTES = 8 * HTB;
__host__ __device__ __forceinline__ int lds_byte(int r, int c) { const int st = (r >> 4) * 2 + (c >> 5), rr = r & 15, cc = c & 31, ob = rr * 64 + cc * 2; return st * 1024 + (ob ^ (((ob >> 9) & 1) << 5)); }
__host__ __device__ __forceinline__ void stage_rc(int b, int& R, int& C) { const int st = b / 1024, sb = b % 1024, swz = sb ^ (((sb >> 9) & 1) << 5); R = (st >> 1) * 16 + swz / 64; C = (st & 1) * 32 + (swz % 64) / 2; }
__host__ __device__ __forceinline__ int perm32(int rho) { const int n = rho >> 4, i = rho & 15; return 8 * (i >> 2) + 4 * n + (i & 3); }

struct Unit { const char* B; int pm, pn, aux; };
struct Gemm { const char* A; unsigned lda; int K; };

template <class Epi, class Sched>
__device__ __forceinline__ void gemm_phase(LAS unsigned char* lds, const Gemm g, const Sched& S, const Epi& E) {
    const int tid = threadIdx.x, wid = __builtin_amdgcn_readfirstlane(tid >> 6), lane = tid & 63, wr = wid >> 2, wc = wid & 3, fr = lane & 15, fq = lane >> 4;
    const int K = g.K, nt = K / BK;
    int Rr[2]; unsigned Cb[2], voffB[2];
#pragma unroll
    for (int i = 0; i < 2; ++i) { int R, C; stage_rc(tid * 16 + i * 8192, R, C); const int Rb = Epi::PERM ? ((R & ~31) + perm32(R & 31)) : R;
        Rr[i] = R; Cb[i] = (unsigned)C * 2u; voffB[i] = (unsigned)(Rb * K + C) * 2u; }
    const size_t kstep = (size_t)(BK * 2);
    const size_t hstepB = (size_t)HALF * K * 2;
    const unsigned ldsw = (unsigned)wid * 1024u;
    const int aoff = lds_byte(wr * 64 + fr, fq * 8), boff = lds_byte(wc * 32 + fr, fq * 8);
#define PG8_SA(b, h) (((b) * 2 + (h)) * HTB)
#define PG8_SB(b, h) ((4 + (b) * 2 + (h)) * HTB)
#define PG8_STAGE(bufoff, gbase, voff) do { _Pragma("unroll") for (int _i = 0; _i < 2; ++_i) \
        __builtin_amdgcn_global_load_lds((const unsigned*)((const char*)(gbase) + (voff)[_i]), (LAS unsigned*)(lds + (bufoff) + ldsw + _i * 8192), 16, 0, 0); } while (0)
#define PG8_LDA(dst, b, h) do { _Pragma("unroll") for (int m = 0; m < 4; ++m) _Pragma("unroll") for (int k = 0; k < 2; ++k) dst[m][k] = *(const LAS bf16x8*)(lds + PG8_SA(b, h) + aoff + m * 2048 + k * 1024); } while (0)
#define PG8_LDB(dst, b, h) do { _Pragma("unroll") for (int n = 0; n < 2; ++n) _Pragma("unroll") for (int k = 0; k < 2; ++k) dst[n][k] = *(const LAS bf16x8*)(lds + PG8_SB(b, h) + boff + n * 2048 + k * 1024); } while (0)
#define PG8_MMA(ai, bj, At, Bt) do { __builtin_amdgcn_s_setprio(1); _Pragma("unroll") for (int m = 0; m < 4; ++m) _Pragma("unroll") for (int n = 0; n < 2; ++n) _Pragma("unroll") for (int k = 0; k < 2; ++k) \
        acc[ai][bj][m][n] = __builtin_amdgcn_mfma_f32_16x16x32_bf16(Bt[n][k], At[m][k], acc[ai][bj][m][n], 0, 0, 0); __builtin_amdgcn_s_setprio(0); } while (0)
#define PG8_WAIT_V(n) asm volatile("s_waitcnt vmcnt(" #n ")" ::: "memory")
#define PG8_WAIT_L(n) asm volatile("s_waitcnt lgkmcnt(" #n ")" ::: "memory")
#define PG8_BAR __builtin_amdgcn_s_barrier()
#define PG8_SCHED __builtin_amdgcn_sched_barrier(0)
#define PG8_SETVA(dst, U) do { _Pragma("unroll") for (int _h = 0; _h < 2; ++_h) _Pragma("unroll") for (int _i = 0; _i < 2; ++_i) \
        dst[_h][_i] = (unsigned)S.arow(U, _h * HALF + Rr[_i]) * g.lda + Cb[_i]; } while (0)
    Unit cur, nxt; int ui = 0;
    if (!S.next(0, cur)) return;
    f32x4 acc[2][2][4][2];
#pragma unroll
    for (int a = 0; a < 2; ++a)
#pragma unroll
        for (int b = 0; b < 2; ++b)
#pragma unroll
            for (int m = 0; m < 4; ++m)
#pragma unroll
                for (int n = 0; n < 2; ++n) acc[a][b][m][n] = (f32x4){0.f, 0.f, 0.f, 0.f};
    bf16x8 At[4][2], B0[2][2], B1[2][2];
    unsigned vAc[2][2], vAn[2][2];
    PG8_SETVA(vAc, cur);
    const char* const gA = g.A;
    const char* cB = cur.B;
    PG8_STAGE(PG8_SB(0, 0), cB, voffB); PG8_STAGE(PG8_SB(0, 1), cB + hstepB, voffB); PG8_STAGE(PG8_SA(0, 0), gA, vAc[0]); PG8_STAGE(PG8_SA(0, 1), gA, vAc[1]);
    if (wr == 1) PG8_BAR;
    PG8_WAIT_V(2); PG8_BAR;
    PG8_STAGE(PG8_SB(1, 0), cB + kstep, voffB); PG8_STAGE(PG8_SA(1, 0), gA + kstep, vAc[0]); PG8_STAGE(PG8_SB(1, 1), cB + hstepB + kstep, voffB);
    PG8_WAIT_V(6); PG8_BAR;
    for (;;) {
        const bool has_next = S.next(ui + 1, nxt);
        if (has_next) { PG8_SETVA(vAn, nxt); } else { vAn[0][0] = vAc[0][0]; vAn[0][1] = vAc[0][1]; vAn[1][0] = vAc[1][0]; vAn[1][1] = vAc[1][1]; }
        const char* nB = has_next ? nxt.B : cB;
        for (int t = 0; t < nt; t += 2) {
            const bool last = (t == nt - 2);
            const char* a1 = gA + (size_t)(t + 1) * kstep;
            const char* a2 = gA + (size_t)(last ? 0 : (t + 2)) * kstep; const char* b2 = last ? nB : cB + (size_t)(t + 2) * kstep;
            const char* a3 = a2 + kstep; const char* b3 = b2 + kstep;
            unsigned v2[2][2];
            v2[0][0] = last ? vAn[0][0] : vAc[0][0]; v2[0][1] = last ? vAn[0][1] : vAc[0][1]; v2[1][0] = last ? vAn[1][0] : vAc[1][0]; v2[1][1] = last ? vAn[1][1] : vAc[1][1];
            PG8_LDB(B0, 0, 0); PG8_LDB(B1, 0, 1); PG8_SCHED; PG8_LDA(At, 0, 0); PG8_STAGE(PG8_SA(1, 1), a1, vAc[1]);
            PG8_WAIT_V(8); PG8_WAIT_L(0); PG8_BAR; PG8_MMA(0, 0, At, B0); PG8_MMA(0, 1, At, B1); PG8_BAR; PG8_SCHED;
            PG8_LDA(At, 0, 1); PG8_STAGE(PG8_SB(0, 0), b2, voffB); PG8_STAGE(PG8_SB(0, 1), b2 + hstepB, voffB); PG8_STAGE(PG8_SA(0, 0), a2, v2[0]);
            PG8_WAIT_V(8); PG8_WAIT_L(0); PG8_BAR; PG8_MMA(1, 0, At, B0); PG8_MMA(1, 1, At, B1); PG8_BAR; PG8_SCHED;
            PG8_LDB(B0, 1, 0); PG8_LDB(B1, 1, 1); PG8_SCHED; PG8_LDA(At, 1, 0); PG8_STAGE(PG8_SA(0, 1), a2, v2[1]);
            PG8_WAIT_V(8); PG8_WAIT_L(0); PG8_BAR; PG8_MMA(0, 0, At, B0); PG8_MMA(0, 1, At, B1); PG8_BAR; PG8_SCHED;
            PG8_LDA(At, 1, 1); PG8_STAGE(PG8_SB(1, 0), b3, voffB); PG8_STAGE(PG8_SB(1, 1), b3 + hstepB, voffB); PG8_STAGE(PG8_SA(1, 0), a3, v2[0]);
            PG8_WAIT_V(8); PG8_WAIT_L(0); PG8_BAR; PG8_MMA(1, 0, At, B0); PG8_MMA(1, 1, At, B1); PG8_BAR; PG8_SCHED;
        }
        if (wr == 0) PG8_BAR;
        E(acc, cur, wr, wc, fr, fq);
        if (!has_next) break;
#pragma unroll
        for (int a = 0; a < 2; ++a)
#pragma unroll
            for (int b = 0; b < 2; ++b)
#pragma unroll
                for (int m = 0; m < 4; ++m)
#pragma unroll
                    for (int n = 0; n < 2; ++n) acc[a][b][m][n] = (f32x4){0.f, 0.f, 0.f, 0.f};
        cur = nxt; cB = nB; ++ui;
        vAc[0][0] = vAn[0][0]; vAc[0][1] = vAn[0][1]; vAc[1][0] = vAn[1][0]; vAc[1][1] = vAn[1][1];
        if (wr == 1) PG8_BAR;
    }
    PG8_WAIT_V(0);
    PG8_BAR;
#undef PG8_SA
#undef PG8_SB
#undef PG8_STAGE
#undef PG8_LDA
#undef PG8_LDB
#undef PG8_MMA
#undef PG8_WAIT_V
#undef PG8_WAIT_L
#undef PG8_BAR
#undef PG8_SCHED
#undef PG8_SETVA
}

struct DenseOrder {
    int nM, nN, nwg, G, c; const char* Bt; size_t tstepB;
    __device__ void init(int M, int N, int K, int G_, int c_, const void* Bt_) { nM = M / BM; nN = N / BM; nwg = nM * nN; G = G_; c = c_; Bt = (const char*)Bt_; tstepB = (size_t)BM * K * 2; }
    __device__ __forceinline__ bool next(int i, Unit& u) const {
        const long L = (long)i * G + c; if (L >= nwg) return false;
        int wgid = (int)L; { const int q = nwg / 8, r = nwg % 8, xcd = wgid % 8, off = wgid / 8; wgid = (xcd < r ? xcd * (q + 1) : r * (q + 1) + (xcd - r) * q) + off; }
        const int nig = 8 * nN, gid = wgid / nig, fm = gid * 8, gsz = (nM - fm) < 8 ? (nM - fm) : 8;
        u.pm = fm + ((wgid % nig) % gsz); u.pn = (wgid % nig) / gsz; u.aux = 0; u.B = Bt + (size_t)u.pn * tstepB; return true;
    }
    __device__ __forceinline__ int arow(const Unit& u, int r) const { return u.pm * BM + r; }
};
}

using pg8::Unit;
struct EpiProj {
    static constexpr bool PERM = true;
    unsigned char* ws; unsigned char* dout;
    __device__ __forceinline__ void operator()(const f32x4 (&acc)[2][2][4][2], const Unit& u, int wr, int wc, int fr, int fq) const {
        const int pn = u.pn; bf16_t* base; int ldc, colt, act = 0;
        if (pn < 4)       { base = (bf16_t*)(ws + WS_LRUX); ldc = DM;   colt = pn * 256; }
        else if (pn < 8)  { base = (bf16_t*)(ws + WS_GATE); ldc = DM;   colt = (pn - 4) * 256; act = 1; }
        else if (pn < 12) { base = (bf16_t*)(ws + WS_Q);    ldc = DM;   colt = (pn - 8) * 256; }
        else if (pn == 12){ base = (bf16_t*)(ws + WS_K);    ldc = KVW;  colt = 0; }
        else if (pn == 13){ base = (bf16_t*)(ws + WS_V);    ldc = KVW;  colt = 0; }
        else if (pn < 16) { base = (bf16_t*)(ws + WS_QIDX); ldc = 512;  colt = (pn - 14) * 256; }
        else if (pn < 24) { base = (bf16_t*)dout;           ldc = 2048; colt = (pn - 16) * 256; act = 2; }
        else              { base = (bf16_t*)(ws + WS_MISC); ldc = 256;  colt = 0; }
        const int row0 = u.pm * 256 + wr * 64 + fr, col0 = colt + wc * 32 + 8 * fq;
#pragma unroll
        for (int ai = 0; ai < 2; ++ai)
#pragma unroll
            for (int m = 0; m < 4; ++m) { bf16_t* rowp = base + (size_t)(row0 + ai * 128 + m * 16) * ldc + col0;
#pragma unroll
                for (int bj = 0; bj < 2; ++bj) { f32x4 v0 = acc[ai][bj][m][0], v1 = acc[ai][bj][m][1];
                    if (act == 1) {
#pragma unroll
                        for (int e = 0; e < 4; ++e) { v0[e] = gelu_tanh(v0[e]); v1[e] = gelu_tanh(v1[e]); } }
                    else if (act == 2) {
#pragma unroll
                        for (int e = 0; e < 4; ++e) { v0[e] = sigmoidf_(v0[e]); v1[e] = sigmoidf_(v1[e]); } }
                    u32x4 w; w.x = cvt_pk_bf16(v0[0], v0[1]); w.y = cvt_pk_bf16(v0[2], v0[3]); w.z = cvt_pk_bf16(v1[0], v1[1]); w.w = cvt_pk_bf16(v1[2], v1[3]);
                    *(u32x4*)(rowp + bj * 128) = w; } }
    }
};
template <bool ADD> struct EpiMerge {
    static constexpr bool PERM = true;
    const bf16_t* sig; int sigoff; const bf16_t* prev; bf16_t* O;
    __device__ __forceinline__ void operator()(const f32x4 (&acc)[2][2][4][2], const Unit& u, int wr, int wc, int fr, int fq) const {
        const int row0 = u.pm * 256 + wr * 64 + fr, col0 = u.pn * 256 + wc * 32 + 8 * fq;
#pragma unroll
        for (int ai = 0; ai < 2; ++ai)
#pragma unroll
            for (int m = 0; m < 4; ++m) { const size_t row = (size_t)(row0 + ai * 128 + m * 16);
#pragma unroll
                for (int bj = 0; bj < 2; ++bj) { const int col = col0 + bj * 128;
                    const u32x4 sg = *(const u32x4*)(sig + row * 2048 + sigoff + col);
                    f32x4 v0 = acc[ai][bj][m][0], v1 = acc[ai][bj][m][1];
                    v0[0] *= bflo(sg.x); v0[1] *= bfhi(sg.x); v0[2] *= bflo(sg.y); v0[3] *= bfhi(sg.y);
                    v1[0] *= bflo(sg.z); v1[1] *= bfhi(sg.z); v1[2] *= bflo(sg.w); v1[3] *= bfhi(sg.w);
                    if (ADD) { const u32x4 pv = *(const u32x4*)(prev + row * DM + col);
                        v0[0] += bflo(pv.x); v0[1] += bfhi(pv.x); v0[2] += bflo(pv.y); v0[3] += bfhi(pv.y);
                        v1[0] += bflo(pv.z); v1[1] += bfhi(pv.z); v1[2] += bflo(pv.w); v1[3] += bfhi(pv.w); }
                    u32x4 w; w.x = cvt_pk_bf16(v0[0], v0[1]); w.y = cvt_pk_bf16(v0[2], v0[3]); w.z = cvt_pk_bf16(v1[0], v1[1]); w.w = cvt_pk_bf16(v1[2], v1[3]);
                    *(u32x4*)(O + row * DM + col) = w; } }
    }
};
struct EpiResid {
    static constexpr bool PERM = true;
    const float* x; bf16_t* xmid;
    __device__ __forceinline__ void operator()(const f32x4 (&acc)[2][2][4][2], const Unit& u, int wr, int wc, int fr, int fq) const {
        const int row0 = u.pm * 256 + wr * 64 + fr, col0 = u.pn * 256 + wc * 32 + 8 * fq;
#pragma unroll
        for (int ai = 0; ai < 2; ++ai)
#pragma unroll
            for (int m = 0; m < 4; ++m) { const size_t off = (size_t)(row0 + ai * 128 + m * 16) * DM + col0;
#pragma unroll
                for (int bj = 0; bj < 2; ++bj) { const f32x4 x0 = *(const f32x4*)(x + off + bj * 128), x1 = *(const f32x4*)(x + off + bj * 128 + 4);
                    const f32x4 v0 = x0 + acc[ai][bj][m][0], v1 = x1 + acc[ai][bj][m][1];
                    u32x4 w; w.x = cvt_pk_bf16(v0[0], v0[1]); w.y = cvt_pk_bf16(v0[2], v0[3]); w.z = cvt_pk_bf16(v1[0], v1[1]); w.w = cvt_pk_bf16(v1[2], v1[3]);
                    *(u32x4*)(xmid + off + bj * 128) = w; } }
    }
};
struct EpiGlu {
    static constexpr bool PERM = true;
    bf16_t* act; const float* rstdE;
    __device__ __forceinline__ void operator()(const f32x4 (&acc)[2][2][4][2], const Unit& u, int wr, int wc, int fr, int fq) const {
        const int row0 = u.pm * 256 + wr * 64 + fr, col0 = u.pn * 128 + wc * 32 + 8 * fq;
        const float* rp = rstdE + (size_t)(u.aux >> 7) * NTOK + (u.aux & 127) * 256 + wr * 64 + fr;
#pragma unroll
        for (int ai = 0; ai < 2; ++ai)
#pragma unroll
            for (int m = 0; m < 4; ++m) { const size_t row = (size_t)(row0 + ai * 128 + m * 16); const float rs = rp[ai * 128 + m * 16];
                f32x4 v0, v1;
#pragma unroll
                for (int e = 0; e < 4; ++e) { const float g0 = acc[ai][0][m][0][e] * rs, g1 = acc[ai][0][m][1][e] * rs;
                    v0[e] = g0 * sigmoidf_(g0) * (acc[ai][1][m][0][e] * rs); v1[e] = g1 * sigmoidf_(g1) * (acc[ai][1][m][1][e] * rs); }
                u32x4 w; w.x = cvt_pk_bf16(v0[0], v0[1]); w.y = cvt_pk_bf16(v0[2], v0[3]); w.z = cvt_pk_bf16(v1[0], v1[1]); w.w = cvt_pk_bf16(v1[2], v1[3]);
                *(u32x4*)(act + row * EFF + col0) = w; }
    }
};
struct EpiScale {
    static constexpr bool PERM = true;
    const float* gateE; bf16_t* y;
    __device__ __forceinline__ void operator()(const f32x4 (&acc)[2][2][4][2], const Unit& u, int wr, int wc, int fr, int fq) const {
        const int e = u.aux >> 7, j = u.aux & 127;
        const float* gp = gateE + (size_t)e * NTOK + j * 256;
        const int rl0 = wr * 64 + fr, col0 = u.pn * 256 + wc * 32 + 8 * fq;
#pragma unroll
        for (int ai = 0; ai < 2; ++ai)
#pragma unroll
            for (int m = 0; m < 4; ++m) { const int rl = rl0 + ai * 128 + m * 16; const float gt = gp[rl]; const size_t row = (size_t)(u.pm * 256 + rl);
#pragma unroll
                for (int bj = 0; bj < 2; ++bj) { const f32x4 v0 = acc[ai][bj][m][0] * gt, v1 = acc[ai][bj][m][1] * gt;
                    u32x4 w; w.x = cvt_pk_bf16(v0[0], v0[1]); w.y = cvt_pk_bf16(v0[2], v0[3]); w.z = cvt_pk_bf16(v1[0], v1[1]); w.w = cvt_pk_bf16(v1[2], v1[3]);
                    *(u32x4*)(y + row * DM + col0 + bj * 128) = w; } }
    }
};

typedef GAS unsigned gu32;
#define XB_TMO      128
#define XB_XCNT(j)  (256  + 64 * (j))
#define XB_XSUB(j)  (1280 + 64 * (j))
#define XB_XGEN(j)  (2304 + 64 * (j))
#define XB_TOP      3328
#define XB_TOPGEN   3392
#define XCD_BAR_WORDS 3456
#define XB_SPIN_CAP (1u << 18)
__device__ __forceinline__ unsigned xb_ld(unsigned* p)              { return __hip_atomic_load(p, __ATOMIC_RELAXED, __HIP_MEMORY_SCOPE_AGENT); }
__device__ __forceinline__ unsigned xb_add(unsigned* p, unsigned v) { return __hip_atomic_fetch_add(p, v, __ATOMIC_RELAXED, __HIP_MEMORY_SCOPE_AGENT); }
__device__ __forceinline__ unsigned xb_xcc_id() { return (unsigned)__builtin_amdgcn_s_getreg((3 << 11) | 20) & 0xFu; }
#define XB_SPIN(cond, bar) do { unsigned _sp = 0; while (cond) { __builtin_amdgcn_s_sleep(1); \
    if ((++_sp & 255u) == 0u) { if (xb_ld(&(bar)[XB_TMO])) break; if (_sp > XB_SPIN_CAP) { atomicAdd(&(bar)[XB_TMO], 1u); break; } } } } while (0)
struct XcdBarrier { unsigned* bar; unsigned x; volatile LAS unsigned* st; };
__device__ __forceinline__ XcdBarrier xcd_barrier_post(unsigned* bar, volatile LAS unsigned* st) {
    XcdBarrier b; b.bar = bar; b.x = xb_xcc_id(); b.st = st;
    if (threadIdx.x == 0) (void)xb_add(&bar[XB_XCNT(b.x)], 1u);
    return b;
}
__device__ __forceinline__ void xcd_barrier_complete(unsigned* bar, unsigned x, unsigned& nloc, unsigned& nx) {
    const unsigned G = gridDim.x * gridDim.y * gridDim.z;
    unsigned sum, cnt, mine, sp = 0u;
    for (;;) {
        sum = 0u; cnt = 0u; mine = 0u;
#pragma unroll
        for (unsigned j = 0; j < 16; ++j) { const unsigned c = xb_ld(&bar[XB_XCNT(j)]); sum += c; cnt += (c > 0u) ? 1u : 0u; mine = (j == x) ? c : mine; }
        if (sum == G) break;
        __builtin_amdgcn_s_sleep(1);
        if ((++sp & 255u) == 0u) { if (xb_ld(&bar[XB_TMO])) break; if (sp > XB_SPIN_CAP) { atomicAdd(&bar[XB_TMO], 1u); break; } }
    }
    nloc = mine > 0u ? mine : 1u; nx = cnt > 0u ? cnt : 1u;
}
__device__ __forceinline__ void xcd_barrier(const XcdBarrier& b) {
    asm volatile("s_waitcnt vmcnt(0)" ::: "memory");
    __syncthreads();
    if (threadIdx.x == 0) {
        unsigned* bar = b.bar;
        __builtin_amdgcn_s_waitcnt(0);
        unsigned nloc = b.st[0], nx = b.st[1];
        if (nloc == 0u) { xcd_barrier_complete(bar, b.x, nloc, nx); b.st[0] = nloc; b.st[1] = nx; }
        const unsigned old = xb_add(&bar[XB_XSUB(b.x)], 1u);
        const unsigned gen = old / nloc;
        if (old + 1u == (gen + 1u) * nloc) {
            __builtin_amdgcn_fence(__ATOMIC_RELEASE, "agent");
            asm volatile("s_waitcnt vmcnt(0)" ::: "memory");
            const unsigned og = xb_add(&bar[XB_TOP], 1u);
            const unsigned tg = og / nx;
            if (og + 1u == (tg + 1u) * nx) xb_add(&bar[XB_TOPGEN], 1u);
            else XB_SPIN(xb_ld(&bar[XB_TOPGEN]) == tg, bar);
            __builtin_amdgcn_fence(__ATOMIC_ACQUIRE, "agent");
            xb_add(&bar[XB_XGEN(b.x)], 1u);
            asm volatile("s_waitcnt vmcnt(0)" ::: "memory");
        } else {
            XB_SPIN(xb_ld(&bar[XB_XGEN(b.x)]) == gen, bar);
            __builtin_amdgcn_fence(__ATOMIC_ACQUIRE, "agent");
            asm volatile("s_waitcnt vmcnt(0)" ::: "memory");
        }
    }
    __syncthreads();
}

constexpr int NWAVES = 8;
constexpr int RING_BYTES = 131072, LDSCTL_OFF = 147456, MISC_OFF = LDSCTL_OFF + 320, LDS_BYTES = 151552;
constexpr int N_PHASES = 12;
#ifndef MK_N_LAUNCHES
#define MK_N_LAUNCHES 1
#endif
struct Args { const void* in[24]; float* out; unsigned char* ws; int ph_lo, ph_hi; };
struct Frame {
    LAS unsigned char* lds; volatile LAS unsigned* MISC; unsigned* ctl; unsigned char* ws;
    int tid, lane, wave, vcu, G;
};

template <class CMap>
__device__ __forceinline__ void p0_transpose_item(const float* W, int ldw, bf16_t* WT, int Kd, LAS float* scr, int kb, int nb, int lane, const CMap& cmap, const float* ksc = nullptr) {
    const int k0 = 64 * kb, n0 = 32 * nb;
    const int kr = lane >> 3, nq = lane & 7; const int sc = cmap(n0 + 4 * nq);
    f32x4 v[8];
#pragma unroll
    for (int i = 0; i < 8; ++i) v[i] = sc >= 0 ? *(const f32x4*)(W + (size_t)(k0 + 8 * i + kr) * ldw + sc) : (f32x4){0.f, 0.f, 0.f, 0.f};
#pragma unroll
    for (int i = 0; i < 8; ++i) { LAS float* d = scr + (8 * i + kr) * 33 + 4 * nq; d[0] = v[i].x; d[1] = v[i].y; d[2] = v[i].z; d[3] = v[i].w; }
    LDS_WAIT(); asm volatile("" ::: "memory");
    const int c = lane & 7;
    f32x4 g0 = (f32x4){1.f, 1.f, 1.f, 1.f}, g1 = g0;
    if (ksc) { g0 = *(const f32x4*)(ksc + k0 + 8 * c); g1 = *(const f32x4*)(ksc + k0 + 8 * c + 4); }
#pragma unroll
    for (int j = 0; j < 4; ++j) { const int n = (lane >> 3) + 8 * j; const LAS float* s = scr + (8 * c) * 33 + n;
        u32x4 o; o.x = pk2(s[0 * 33] * g0.x, s[1 * 33] * g0.y); o.y = pk2(s[2 * 33] * g0.z, s[3 * 33] * g0.w); o.z = pk2(s[4 * 33] * g1.x, s[5 * 33] * g1.y); o.w = pk2(s[6 * 33] * g1.z, s[7 * 33] * g1.w);
        *(GAS u32x4*)(WT + (size_t)(n0 + n) * Kd + k0 + 8 * c) = o; }
    LDS_WAIT(); asm volatile("" ::: "memory");
}
struct CMapId { __device__ __forceinline__ int operator()(int n) const { return n; } };
struct CMapWin {
    __device__ __forceinline__ int operator()(int n) const { return n < 4096 ? n : n < 6144 ? 4168 + (n - 4096) : n < 6208 ? 4096 + (n - 6144) : n < 6216 ? 4160 + (n - 6208) : -1; } };
struct CMapW13 {
    __device__ __forceinline__ int operator()(int n) const { const int pn = n >> 8, bj = (n >> 7) & 1, j = n & 127; return 512 * bj + 128 * pn + j; } };

constexpr int I_WIN = 16 * (NP / 32), I_SQ = 16 * 32, I_W13 = 32 * 16 * 32, I_W2 = 32 * 8 * 32, I_G = 16 * 2 * 4;
constexpr int DEF_W13 = 5120;
__device__ __forceinline__ void p0_item_w13(const Args& a, unsigned char* ws, int r, LAS float* scr, int lane) {
    const int e = r / 512, q = r % 512;
    p0_transpose_item((const float*)a.in[22] + (size_t)e * DM * 1024, 1024, (bf16_t*)(ws + WS_W13) + (size_t)e * 1024 * DM, DM, scr, q / 32, q % 32, lane, CMapW13(), (const float*)a.in[17]);
}
__device__ __forceinline__ void p0_item_w2(const Args& a, unsigned char* ws, int r, LAS float* scr, int lane) {
    const int e = r / 256, q = r % 256;
    p0_transpose_item((const float*)a.in[23] + (size_t)e * EFF * DM, DM, (bf16_t*)(ws + WS_W2) + (size_t)e * DM * EFF, EFF, scr, q / 32, q % 32, lane, CMapId());
}
template <class Fn> __device__ __forceinline__ void tail_items(const Frame& F, int c, int rem, int lo, int hi, const Fn& fn) {
    const int nid = rem ? F.G - rem : F.G, idx = rem ? c - rem : c;
    if (idx < 0) return;
    for (int r = lo + idx * NWAVES + F.wave; r < hi; r += nid * NWAVES) fn(r);
}
__device__ __forceinline__ void p0_prologue(Frame& F, const Args& a) {
    LAS float* scr = (LAS float*)(F.lds + F.wave * 16384);
    const int gw = F.vcu * NWAVES + F.wave, NGW = F.G * NWAVES, lane = F.lane;
    unsigned char* ws = F.ws;
    constexpr int NITEMS = I_WIN + 3 * I_SQ + I_G;
    for (int it = gw; it < NITEMS; it += NGW) {
        int r = it;
        if (r < I_WIN) { p0_transpose_item((const float*)a.in[3], IN_COLS, (bf16_t*)(ws + WS_WIN), DM, scr, r / (NP / 32), r % (NP / 32), lane, CMapWin()); continue; } r -= I_WIN;
        if (r < I_SQ) { p0_transpose_item((const float*)a.in[14], DM, (bf16_t*)(ws + WS_WA), DM, scr, r / 32, r % 32, lane, CMapId()); continue; } r -= I_SQ;
        if (r < I_SQ) { p0_transpose_item((const float*)a.in[15], DM, (bf16_t*)(ws + WS_WB), DM, scr, r / 32, r % 32, lane, CMapId()); continue; } r -= I_SQ;
        if (r < I_SQ) { p0_transpose_item((const float*)a.in[16], DM, (bf16_t*)(ws + WS_WO), DM, scr, r / 32, r % 32, lane, CMapId()); continue; } r -= I_SQ;
        { const int blk = r >> 3, q = r & 7, gate = blk & 1, n = blk >> 1;
          const float* src = (const float*)(gate ? a.in[8] : a.in[6]) + (size_t)n * 128 * 128;
          p0_transpose_item(src, 128, (bf16_t*)(ws + WS_WG) + (size_t)blk * 128 * 128, 128, scr, q >> 2, q & 3, lane, CMapId()); }
    }
    const float* x = (const float*)a.in[0]; const float* g1 = (const float*)a.in[2];
    f32x4 gv[4];
#pragma unroll
    for (int j = 0; j < 4; ++j) gv[j] = ((const f32x4*)g1)[lane + 64 * j];
    if (gw < NTOK) {
        f32x4 v[4];
#pragma unroll
        for (int j = 0; j < 4; ++j) v[j] = ((const GAS f32x4*)(x + (size_t)gw * DM) + lane)[64 * j];
        for (int m = gw; m < NTOK; m += NGW) {
            const int mn = m + NGW < NTOK ? m + NGW : m; f32x4 vn[4];
#pragma unroll
            for (int j = 0; j < 4; ++j) vn[j] = ((const GAS f32x4*)(x + (size_t)mn * DM) + lane)[64 * j];
            float s = 0.f;
#pragma unroll
            for (int j = 0; j < 4; ++j) s += (v[j].x * v[j].x + v[j].y * v[j].y) + (v[j].z * v[j].z + v[j].w * v[j].w);
            const float rstd = 1.0f / sqrtf(wave_sum(s) * (1.f / DM) + NORM_EPS);
            GAS u32x2* o8 = (GAS u32x2*)((bf16_t*)(ws + WS_XN) + (size_t)m * DM) + lane;
#pragma unroll
            for (int j = 0; j < 4; ++j) { u32x2 o; o.x = pk2(v[j].x * rstd * gv[j].x, v[j].y * rstd * gv[j].y); o.y = pk2(v[j].z * rstd * gv[j].z, v[j].w * rstd * gv[j].w); o8[64 * j] = o; }
#pragma unroll
            for (int j = 0; j < 4; ++j) v[j] = vn[j];
        }
    }
    { const int* pos = (const int*)a.in[1]; float* rope = (float*)(ws + WS_ROPE);
      const int gt = (F.vcu * NWAVES + F.wave) * 64 + lane, NGT = NGW * 64;
      for (int i = gt; i < NTOK * 24; i += NGT) { const int t = i / 24, f = i % 24; const float p = (float)pos[t];
          if (f < 16) { const float inv = powf(500000.0f, -(float)(2 * f) / 32.0f); const float ang = p * inv; rope[(size_t)t * 16 + f] = cosf(ang); rope[(size_t)NTOK * 16 + (size_t)t * 16 + f] = sinf(ang); }
          else { const int f2 = f - 16; const float inv = powf(500000.0f, -(float)(2 * f2) / 16.0f); const float ang = p * inv; rope[(size_t)NTOK * 32 + (size_t)t * 8 + f2] = cosf(ang); rope[(size_t)NTOK * 40 + (size_t)t * 8 + f2] = sinf(ang); } }
      const float* g2 = (const float*)a.in[17]; const float* wg = (const float*)a.in[18]; const float* we = (const float*)a.in[20]; float* wrt = (float*)(ws + WS_WR);
      for (int i = gt; i < 36 * DM; i += NGT) { const int c = i / DM, k = i % DM; wrt[i] = g2[k] * (c < 4 ? wg[k * 4 + c] : we[k * 32 + (c - 4)]); } }
}

template <int EPL, bool NORM>
__device__ __forceinline__ void norm_rope_regs(float (&x)[EPL], const float* g, const float (&cs)[EPL], const float (&sn)[EPL], float scale, int lane) {
    const int hl = lane & 7;
    if (NORM) { float ss = 0.f;
#pragma unroll
        for (int e = 0; e < EPL; ++e) ss += x[e] * x[e];
        ss += __shfl_xor(ss, 1); ss += __shfl_xor(ss, 2); ss += __shfl_xor(ss, 4);
        const float rstd = 1.0f / sqrtf(ss * (1.0f / (8 * EPL)) + NORM_EPS);
#pragma unroll
        for (int e = 0; e < EPL; e += 4) { const f32x4 gv = *(const f32x4*)(g + hl * EPL + e); x[e] *= rstd * gv.x; x[e + 1] *= rstd * gv.y; x[e + 2] *= rstd * gv.z; x[e + 3] *= rstd * gv.w; } }
#pragma unroll
    for (int e = 0; e < EPL; ++e) { const float p = __shfl_xor(x[e], 1); const float c = cs[e], sv = sn[e];
        const float r0 = x[e] * c - p * sv, r1 = x[e] * c + p * sv; x[e] = (hl == 0 ? r0 : hl == 1 ? r1 : x[e]) * scale; }
}
__device__ __forceinline__ unsigned fp8x4(float a, float b, float c, float d) { int r = __builtin_amdgcn_cvt_pk_fp8_f32(a, b, 0, false); r = __builtin_amdgcn_cvt_pk_fp8_f32(c, d, r, true); return (unsigned)r; }
__device__ __forceinline__ void unpk8(const u32x4 a, float* x) { x[0] = bflo(a.x); x[1] = bfhi(a.x); x[2] = bflo(a.y); x[3] = bfhi(a.y); x[4] = bflo(a.z); x[5] = bfhi(a.z); x[6] = bflo(a.w); x[7] = bfhi(a.w); }
__device__ __forceinline__ u32x4 pk8(const float* x) { u32x4 a; a.x = pk2(x[0], x[1]); a.y = pk2(x[2], x[3]); a.z = pk2(x[4], x[5]); a.w = pk2(x[6], x[7]); return a; }
constexpr float QSCALE = 0.08838834764831845f * 1.4426950408889634f;
struct PPTok { u32x4 q0, q1, k0, k1, v0, v1, qi, ki; f32x4 cm[4], sm[4], ci[2], si[2]; unsigned wr; };
__device__ __forceinline__ void pp_load(PPTok& T, unsigned char* ws, int t, int lane) {
    const float* rope = (const float*)(ws + WS_ROPE);
    const bf16_t* q = (const bf16_t*)(ws + WS_Q) + (size_t)t * DM + lane * 16; T.q0 = *(const u32x4*)q; T.q1 = *(const u32x4*)(q + 8);
    const bf16_t* k = (const bf16_t*)(ws + WS_K) + (size_t)t * KVW + (lane & 15) * 16; T.k0 = *(const u32x4*)k; T.k1 = *(const u32x4*)(k + 8);
    const bf16_t* v = (const bf16_t*)(ws + WS_V) + (size_t)t * KVW + (lane & 15) * 16; T.v0 = *(const u32x4*)v; T.v1 = *(const u32x4*)(v + 8);
    T.qi = *(const u32x4*)((const bf16_t*)(ws + WS_QIDX) + (size_t)t * 512 + lane * 8);
    const bf16_t* ms = (const bf16_t*)(ws + WS_MISC) + (size_t)t * 256; T.ki = *(const u32x4*)(ms + (lane & 7) * 8); T.wr = ms[64 + (lane & 7)];
#pragma unroll
    for (int i = 0; i < 4; ++i) { T.cm[i] = *(const f32x4*)(rope + (size_t)t * 16 + 4 * i); T.sm[i] = *(const f32x4*)(rope + (size_t)NTOK * 16 + (size_t)t * 16 + 4 * i); }
#pragma unroll
    for (int i = 0; i < 2; ++i) { T.ci[i] = *(const f32x4*)(rope + (size_t)NTOK * 32 + (size_t)t * 8 + 4 * i); T.si[i] = *(const f32x4*)(rope + (size_t)NTOK * 40 + (size_t)t * 8 + 4 * i); }
}
__device__ __forceinline__ void pp_finish(const PPTok& T, unsigned char* ws, const Args& a, int t, int lane) {
    const float* qg = (const float*)a.in[11]; const float* kg = (const float*)a.in[12]; const float* ig = (const float*)a.in[13];
    float cm[16], sm[16], ci[8], si[8];
#pragma unroll
    for (int i = 0; i < 4; ++i) { cm[4 * i] = T.cm[i].x; cm[4 * i + 1] = T.cm[i].y; cm[4 * i + 2] = T.cm[i].z; cm[4 * i + 3] = T.cm[i].w; sm[4 * i] = T.sm[i].x; sm[4 * i + 1] = T.sm[i].y; sm[4 * i + 2] = T.sm[i].z; sm[4 * i + 3] = T.sm[i].w; }
#pragma unroll
    for (int i = 0; i < 2; ++i) { ci[4 * i] = T.ci[i].x; ci[4 * i + 1] = T.ci[i].y; ci[4 * i + 2] = T.ci[i].z; ci[4 * i + 3] = T.ci[i].w; si[4 * i] = T.si[i].x; si[4 * i + 1] = T.si[i].y; si[4 * i + 2] = T.si[i].z; si[4 * i + 3] = T.si[i].w; }
    { float x[16]; unpk8(T.q0, x); unpk8(T.q1, x + 8); norm_rope_regs<16, true>(x, qg, cm, sm, 1.0f, lane);
      bf16_t* q = (bf16_t*)(ws + WS_Q) + (size_t)t * DM + lane * 16; *(u32x4*)q = pk8(x); *(u32x4*)(q + 8) = pk8(x + 8); }
    { float x[16]; unpk8(T.k0, x); unpk8(T.k1, x + 8); norm_rope_regs<16, true>(x, kg, cm, sm, 1.0f, lane);
      if (lane < 16) { u32x4 o; o.x = fp8x4(x[0], x[1], x[2], x[3]); o.y = fp8x4(x[4], x[5], x[6], x[7]); o.z = fp8x4(x[8], x[9], x[10], x[11]); o.w = fp8x4(x[12], x[13], x[14], x[15]);
          *(u32x4*)(ws + WS_K8 + (size_t)t * 256 + lane * 16) = o;
          float y[16]; unpk8(T.v0, y); unpk8(T.v1, y + 8);
          o.x = fp8x4(y[0], y[1], y[2], y[3]); o.y = fp8x4(y[4], y[5], y[6], y[7]); o.z = fp8x4(y[8], y[9], y[10], y[11]); o.w = fp8x4(y[12], y[13], y[14], y[15]);
          *(u32x4*)(ws + WS_V8 + (size_t)t * 256 + lane * 16) = o; } }
    { float x[8]; unpk8(T.qi, x); norm_rope_regs<8, false>(x, ig, ci, si, 1.0f, lane); *(u32x4*)((bf16_t*)(ws + WS_QIDX) + (size_t)t * 512 + lane * 8) = pk8(x); }
    { float x[8]; unpk8(T.ki, x); norm_rope_regs<8, true>(x, ig, ci, si, 1.0f, lane); if (lane < 8) *(u32x4*)(ws + WS_KIDX + (size_t)(t >> 5) * 4096 + lane * 512 + (t & 31) * 16) = pk8(x); }
    if (lane < 8) ((float*)(ws + WS_WIDX))[(size_t)t * 8 + lane] = bf2f((unsigned short)T.wr) * 0.044194173824159216f;
}
__device__ __forceinline__ void p2_postproj(Frame& F, const Args& a) {
    const int gw = F.vcu * NWAVES + F.wave, NGW = F.G * NWAVES, lane = F.lane; unsigned char* ws = F.ws;
    if (gw >= NTOK) return;
    PPTok cur; pp_load(cur, ws, gw, lane);
    for (int t = gw; t < NTOK; t += NGW) {
        PPTok nxt; const int tn = t + NGW < NTOK ? t + NGW : t; pp_load(nxt, ws, tn, lane);
        pp_finish(cur, ws, a, t, lane);
        cur = nxt;
    }
}

constexpr int LRU_TC = 256, LRU_L = 64, LRU_NSC = SEQ / LRU_L, XA_STRIDE = 272, LRU_XA_BYTES = LRU_TC * XA_STRIDE, LRU_GT_OFF = 76800;
template <int PASS>
__device__ __forceinline__ void lru_unit(Frame& F, const Args& a, int b, int n, int j) {
    unsigned char* ws = F.ws; const int tid = F.tid, lane = F.lane, wave = F.wave;
    LAS unsigned char* xa = F.lds;
    LAS float* partA = (LAS float*)(F.lds + LRU_XA_BYTES); LAS float* partH = partA + 512; LAS float* carry = partH + 512;
    const int t0 = j * LRU_TC;
    float* lsA = (float*)(ws + WS_LSUM); float* lsH = lsA + (size_t)NB * LRU_NSC * DM;
    {
        const int cg = tid & 15, rg = tid >> 4; const int chb = 128 * n + 8 * cg;
        const bf16_t* X = (const bf16_t*)(ws + WS_LRUX) + (size_t)(b * SEQ) * DM + chb;
        const float* cw = (const float*)a.in[4]; const float* cbp = (const float*)a.in[5];
        float w[4][8], bias[8];
#pragma unroll
        for (int k = 0; k < 4; ++k) { const f32x4 u0 = *(const f32x4*)(cw + k * DM + chb), u1 = *(const f32x4*)(cw + k * DM + chb + 4);
            w[k][0] = u0.x; w[k][1] = u0.y; w[k][2] = u0.z; w[k][3] = u0.w; w[k][4] = u1.x; w[k][5] = u1.y; w[k][6] = u1.z; w[k][7] = u1.w; }
        { const f32x4 u0 = *(const f32x4*)(cbp + chb), u1 = *(const f32x4*)(cbp + chb + 4); bias[0] = u0.x; bias[1] = u0.y; bias[2] = u0.z; bias[3] = u0.w; bias[4] = u1.x; bias[5] = u1.y; bias[6] = u1.z; bias[7] = u1.w; }
        u32x4 xr[11];
#pragma unroll
        for (int i = 0; i < 11; ++i) { const int tt = t0 + 8 * rg - 3 + i; xr[i] = tt >= 0 ? *(const u32x4*)(X + (size_t)tt * DM) : (u32x4){0u, 0u, 0u, 0u}; }
#pragma unroll
        for (int r = 0; r < 8; ++r) { float o[8];
#pragma unroll
            for (int e = 0; e < 8; ++e) o[e] = bias[e];
#pragma unroll
            for (int k = 0; k < 4; ++k) { const u32x4 v = xr[r + k];
                o[0] += w[k][0] * bflo(v.x); o[1] += w[k][1] * bfhi(v.x); o[2] += w[k][2] * bflo(v.y); o[3] += w[k][3] * bfhi(v.y);
                o[4] += w[k][4] * bflo(v.z); o[5] += w[k][5] * bfhi(v.z); o[6] += w[k][6] * bflo(v.w); o[7] += w[k][7] * bfhi(v.w); }
            u32x4 pkd; pkd.x = pk2(o[0], o[1]); pkd.y = pk2(o[2], o[3]); pkd.z = pk2(o[4], o[5]); pkd.w = pk2(o[6], o[7]);
            *(LAS u32x4*)(xa + (8 * rg + r) * XA_STRIDE + cg * 16) = pkd; }
    }
    LAS unsigned char* gt = F.lds + LRU_GT_OFF;
    if (PASS == 1) {
        const int cg = tid & 15, rg = tid >> 4; const bf16_t* G = (const bf16_t*)(ws + WS_GATE) + (size_t)(b * SEQ + t0) * DM + 128 * n + 8 * cg;
        asm volatile("" ::: "memory");
#pragma unroll 2
        for (int r = 0; r < 8; ++r) *(LAS u32x4*)(gt + (8 * rg + r) * XA_STRIDE + cg * 16) = *(const u32x4*)(G + (size_t)(8 * rg + r) * DM);
        asm volatile("" ::: "memory");
    }
    if (PASS == 1) {
        const int chl = tid & 127, part = tid >> 7; const size_t cb = (size_t)b * LRU_NSC * DM + 128 * n + chl;
        float Ac = 1.f, Hc = 0.f;
        for (int s = part * j; s < (part + 1) * j; ++s) { const float As = lsA[cb + (size_t)s * DM], Hs = lsH[cb + (size_t)s * DM]; Hc = As * Hc + Hs; Ac = As * Ac; }
        partA[part * 128 + chl] = Ac; partH[part * 128 + chl] = Hc;
        __syncthreads();
        if (part == 0) { float h = 0.f;
#pragma unroll
            for (int p = 0; p < 4; ++p) h = partA[p * 128 + chl] * h + partH[p * 128 + chl];
            carry[chl] = h;
#pragma unroll
            for (int q = 0; q < 3; ++q) { const int s = 4 * j + q; h = lsA[cb + (size_t)s * DM] * h + lsH[cb + (size_t)s * DM]; carry[(q + 1) * 128 + chl] = h; } }
    }
    __syncthreads();
    {
        const int sb = wave & 3, th = wave >> 2, hh = lane >> 5, d = 32 * sb + (lane & 31), ch = 128 * n + d;
        const bf16_t* WG = (const bf16_t*)(ws + WS_WG);
        bf16x8 Wr[8], Wi[8];
#pragma unroll
        for (int s = 0; s < 8; ++s) { Wr[s] = *(const bf16x8*)(WG + ((size_t)(n * 2 + 0) * 128 + d) * 128 + 16 * s + 8 * hh); Wi[s] = *(const bf16x8*)(WG + ((size_t)(n * 2 + 1) * 128 + d) * 128 + 16 * s + 8 * hh); }
        const float br = ((const float*)a.in[7])[ch], bi = ((const float*)a.in[9])[ch];
        const float sp8 = -8.0f * log1pf(expf(-((const float*)a.in[10])[ch]));
        float h = PASS == 1 ? carry[(2 * th + hh) * 128 + d] : 0.f, P = 1.f;
        const int rA = lane & 31, tlA = (2 * th + ((rA >> 2) & 1)) * 64 + (rA & 3) + 4 * (rA >> 3);
#pragma unroll 1
        for (int i = 0; i < 4; ++i) {
            f32x16 ar, ai;
#pragma unroll
            for (int e = 0; e < 16; ++e) { ar[e] = 0.f; ai[e] = 0.f; }
#pragma unroll
            for (int s = 0; s < 8; ++s) { const bf16x8 af = *(const LAS bf16x8*)(xa + (tlA + 16 * i) * XA_STRIDE + (16 * s + 8 * hh) * 2);
                ar = __builtin_amdgcn_mfma_f32_32x32x16_bf16(af, Wr[s], ar, 0, 0, 0); ai = __builtin_amdgcn_mfma_f32_32x32x16_bf16(af, Wi[s], ai, 0, 0, 0); }
            const int tl0 = (2 * th + hh) * 64 + 16 * i;
#pragma unroll
            for (int e = 0; e < 16; ++e) {
                const int tl = tl0 + e;
                const float xav = bf2f(*(const LAS bf16_t*)(xa + tl * XA_STRIDE + d * 2));
                const float r = sigmoidf_(ar[e] + br), ig = sigmoidf_(ai[e] + bi);
                const float la = sp8 * r, av = fast_exp(la), m2 = __builtin_fmaf(-av, av, 1.0f);
                const float u = __builtin_amdgcn_sqrtf(m2) * ig * xav;
                h = av * h + u;
                if (PASS == 0) P *= av;
                else { LAS bf16_t* gp = (LAS bf16_t*)(gt + tl * XA_STRIDE + d * 2); *gp = (bf16_t)f2bf(h * bf2f(*gp)); }
            }
        }
        if (PASS == 0) { const size_t o = ((size_t)b * LRU_NSC + 4 * j + 2 * th + hh) * DM + ch; lsA[o] = P; lsH[o] = h; }
    }
    __syncthreads();
    if (PASS == 1) {
        const int cg = tid & 15, rg = tid >> 4; bf16_t* Y = (bf16_t*)(ws + WS_XN) + (size_t)(b * SEQ + t0) * DM + 128 * n + 8 * cg;
#pragma unroll 2
        for (int r = 0; r < 8; ++r) *(u32x4*)(Y + (size_t)(8 * rg + r) * DM) = *(const LAS u32x4*)(gt + (8 * rg + r) * XA_STRIDE + cg * 16);
        __syncthreads();
    }
}
template <int PASS> __device__ __forceinline__ void lru_phase(Frame& F, const Args& a) {
    for (int u4 = F.vcu; u4 < 256; u4 += F.G)
        for (int i = 0; i < 4; ++i) { const int uid = u4 * 4 + i; lru_unit<PASS>(F, a, uid >> 8, uid & 7, (uid >> 3) & 31); }
}

__device__ __forceinline__ void p7_router(Frame& F, const Args& a) {
    const int lane = F.lane; unsigned char* ws = F.ws;
    const bf16_t* xm = (const bf16_t*)(ws + WS_XMID); const float* wrt = (const float*)(ws + WS_WR); float* rstdE = (float*)(ws + WS_RSTDE);
    int* tokE = (int*)(ws + WS_TOKE); float* gateE = (float*)(ws + WS_GATEE); int* tinfo = (int*)(ws + WS_TINFO);
    unsigned* ecnt = F.ctl + CW_ECNT;
    LAS float* lg = (LAS float*)(F.lds + F.wave * 4096);
    const int ri = lane & 15, kk = lane >> 4;
    LAS unsigned* lc = (LAS unsigned*)(F.lds + NWAVES * 4096); LAS unsigned* gb = lc + 32;
    for (int mb = F.vcu * (NWAVES * 16); mb < NTOK; mb += F.G * (NWAVES * 16)) {
        const int m0 = mb + F.wave * 16;
        if (F.tid < 32) lc[F.tid] = 0u;
        const u32x4* ap = (const u32x4*)(xm + (size_t)(m0 + ri) * DM) + kk;
        const f32x4* bp0 = (const f32x4*)(wrt + (size_t)(ri) * DM) + 2 * kk;
        const f32x4* bp1 = (const f32x4*)(wrt + (size_t)(16 + ri) * DM) + 2 * kk;
        const f32x4* bp2 = (const f32x4*)(wrt + (size_t)(ri < 4 ? 32 + ri : 35) * DM) + 2 * kk;
        f32x4 acc0 = (f32x4){0.f, 0.f, 0.f, 0.f}, acc1 = acc0, acc2 = acc0; float ssq = 0.f;
#pragma unroll 2
        for (int s = 0; s < 32; ++s) { const u32x4 aw = ap[4 * s];
            const f32x4 b00 = bp0[8 * s], b01 = bp0[8 * s + 1], b10 = bp1[8 * s], b11 = bp1[8 * s + 1], b20 = bp2[8 * s], b21 = bp2[8 * s + 1];
            const f32x4 a0 = (f32x4){bflo(aw.x), bfhi(aw.x), bflo(aw.y), bfhi(aw.y)}, a1 = (f32x4){bflo(aw.z), bfhi(aw.z), bflo(aw.w), bfhi(aw.w)};
            ssq += ((a0.x * a0.x + a0.y * a0.y) + (a0.z * a0.z + a0.w * a0.w)) + ((a1.x * a1.x + a1.y * a1.y) + (a1.z * a1.z + a1.w * a1.w));
#pragma unroll
            for (int e = 0; e < 4; ++e) { acc0 = __builtin_amdgcn_mfma_f32_16x16x4f32(a0[e], b00[e], acc0, 0, 0, 0); acc1 = __builtin_amdgcn_mfma_f32_16x16x4f32(a0[e], b10[e], acc1, 0, 0, 0); acc2 = __builtin_amdgcn_mfma_f32_16x16x4f32(a0[e], b20[e], acc2, 0, 0, 0); }
#pragma unroll
            for (int e = 0; e < 4; ++e) { acc0 = __builtin_amdgcn_mfma_f32_16x16x4f32(a1[e], b01[e], acc0, 0, 0, 0); acc1 = __builtin_amdgcn_mfma_f32_16x16x4f32(a1[e], b11[e], acc1, 0, 0, 0); acc2 = __builtin_amdgcn_mfma_f32_16x16x4f32(a1[e], b21[e], acc2, 0, 0, 0); } }
        ssq += __shfl_xor(ssq, 16); ssq += __shfl_xor(ssq, 32);
        const float rstd = 1.0f / sqrtf(ssq * (1.f / DM) + NORM_EPS);
#pragma unroll
        for (int e = 0; e < 4; ++e) { lg[(4 * kk + e) * 48 + ri] = acc0[e]; lg[(4 * kk + e) * 48 + 16 + ri] = acc1[e]; lg[(4 * kk + e) * 48 + 32 + ri] = acc2[e]; }
        if (kk == 0) lg[768 + ri] = rstd;
        asm volatile("s_waitcnt lgkmcnt(0)" ::: "memory");
        int e1 = 0, e2 = 0; float g1 = 0.f, g2 = 0.f, rs = 0.f;
        if (lane < 16) {
            rs = lg[768 + lane]; const float* bg = (const float*)a.in[19]; const float* be = (const float*)a.in[21];
            float gl[4]; int gs = 0; float gmax = -__builtin_inff();
#pragma unroll
            for (int c = 0; c < 4; ++c) { gl[c] = lg[lane * 48 + c] * rs + bg[c]; if (gl[c] > gmax) { gmax = gl[c]; gs = c; } }
            float gsum = 0.f;
#pragma unroll
            for (int c = 0; c < 4; ++c) gsum += fast_exp(gl[c] - gmax);
            const float pgrp = 1.0f / gsum;
            float m1 = -__builtin_inff(), mx2 = -__builtin_inff(); int j1 = 0, j2 = 0;
            for (int c = 0; c < 8; ++c) { const float v = lg[lane * 48 + 4 + 8 * gs + c] * rs + be[8 * gs + c];
                if (v > m1) { mx2 = m1; j2 = j1; m1 = v; j1 = c; } else if (v > mx2) { mx2 = v; j2 = c; } }
            const float ex = fast_exp(mx2 - m1); g1 = pgrp / (1.0f + ex); g2 = pgrp - g1;
            e1 = 8 * gs + j1; e2 = 8 * gs + j2;
        }
        __syncthreads();
        unsigned l1 = 0u, l2 = 0u;
        if (lane < 16) { l1 = __hip_atomic_fetch_add(lc + e1, 1u, __ATOMIC_RELAXED, __HIP_MEMORY_SCOPE_WORKGROUP); l2 = __hip_atomic_fetch_add(lc + e2, 1u, __ATOMIC_RELAXED, __HIP_MEMORY_SCOPE_WORKGROUP); }
        __syncthreads();
        if (F.tid < 32) { const unsigned n = lc[F.tid]; gb[F.tid] = n ? __hip_atomic_fetch_add(ecnt + 64 * F.tid, n, RLX_AGENT) : 0u; }
        __syncthreads();
        if (lane < 16) { const int tok = m0 + lane, p1 = (int)(gb[e1] + l1), p2 = (int)(gb[e2] + l2);
            tokE[(size_t)e1 * NTOK + p1] = tok; gateE[(size_t)e1 * NTOK + p1] = g1; tokE[(size_t)e2 * NTOK + p2] = tok; gateE[(size_t)e2 * NTOK + p2] = g2;
            rstdE[(size_t)e1 * NTOK + p1] = rs; rstdE[(size_t)e2 * NTOK + p2] = rs;
            *(int4*)(tinfo + (size_t)tok * 4) = make_int4(e1, p1, e2, p2);
        }
        asm volatile("s_waitcnt lgkmcnt(0)" ::: "memory");
    }
}

constexpr int MOE_LDS_OFF = LDSCTL_OFF + 1024;
__device__ __forceinline__ void moe_sched_setup(Frame& F) {
    LAS int* sc = (LAS int*)(F.lds + MOE_LDS_OFF);
    if (F.tid < 32) sc[F.tid] = (int)__hip_atomic_load(F.ctl + CW_ECNT + 64 * F.tid, RLX_AGENT);
    __syncthreads();
    if (F.tid == 0) { int s = 0; for (int e = 0; e < 32; ++e) { sc[32 + e] = s; s += (sc[e] + 255) >> 8; } sc[64] = s; }
    __syncthreads();
}
template <bool GATHER> struct GroupOrder {
    LAS const int* sc; int G, c; const char* W; size_t estride, tstepB; const int* tokE;
    __device__ __forceinline__ bool next(int i, Unit& u) const {
        const int L = i * G + c, TM = sc[64]; if (L >= 4 * TM) return false;
        const int rt = L >> 2, pn = L & 3; int e = 0;
        for (int q = 1; q < 32; ++q) e = sc[32 + q] <= rt ? q : e;
        u.pm = rt; u.pn = pn; u.aux = e * 128 + (rt - sc[32 + e]); u.B = W + (size_t)e * estride + (size_t)pn * tstepB; return true;
    }
    __device__ __forceinline__ int arow(const Unit& u, int r) const {
        if (!GATHER) return u.pm * 256 + r;
        const int e = u.aux >> 7, idx = (u.aux & 127) * 256 + r;
        return idx < sc[e] ? tokE[(size_t)e * NTOK + idx] : 0;
    }
};
__device__ __forceinline__ void p10_combine(Frame& F, const Args& a) {
    const int gw = F.vcu * NWAVES + F.wave, NGW = F.G * NWAVES, lane = F.lane; unsigned char* ws = F.ws;
    LAS const int* sc = (LAS const int*)(F.lds + MOE_LDS_OFF);
    const int* tinfo = (const int*)(ws + WS_TINFO); const bf16_t* y = (const bf16_t*)(ws + WS_Y); float* out = a.out;
    for (int t = gw; t < NTOK; t += NGW) {
        const int4 ti = *(const int4*)(tinfo + (size_t)t * 4);
        const size_t s1 = (size_t)sc[32 + ti.x] * 256 + ti.y, s2 = (size_t)sc[32 + ti.z] * 256 + ti.w;
        GAS f32x4* xr = (GAS f32x4*)(out + (size_t)t * DM) + lane; const GAS u32x2* xm = (const GAS u32x2*)((const bf16_t*)(ws + WS_XMID) + (size_t)t * DM) + lane;
        const GAS u32x2* y1 = (const GAS u32x2*)(y + s1 * DM) + lane; const GAS u32x2* y2 = (const GAS u32x2*)(y + s2 * DM) + lane;
#pragma unroll
        for (int j = 0; j < 4; ++j) { const u32x2 xw = xm[64 * j]; f32x4 v = (f32x4){bflo(xw.x), bfhi(xw.x), bflo(xw.y), bfhi(xw.y)}; const u32x2 p = y1[64 * j], q = y2[64 * j];
            v.x += bflo(p.x) + bflo(q.x); v.y += bfhi(p.x) + bfhi(q.x); v.z += bflo(p.y) + bflo(q.y); v.w += bfhi(p.y) + bfhi(q.y);
            xr[64 * j] = v; }
    }
}


constexpr int CAP = 576, S1_KS = 64;
__device__ __forceinline__ unsigned mbcnt64(unsigned long long m) { return __builtin_amdgcn_mbcnt_hi((unsigned)(m >> 32), __builtin_amdgcn_mbcnt_lo((unsigned)m, 0u)); }
__device__ __forceinline__ unsigned wave_or_u32(unsigned v) {
    v |= (unsigned)__builtin_amdgcn_update_dpp(0, (int)v, 0x121, 0xF, 0xF, false); v |= (unsigned)__builtin_amdgcn_update_dpp(0, (int)v, 0x122, 0xF, 0xF, false);
    v |= (unsigned)__builtin_amdgcn_update_dpp(0, (int)v, 0x124, 0xF, 0xF, false); v |= (unsigned)__builtin_amdgcn_update_dpp(0, (int)v, 0x128, 0xF, 0xF, false);
    return (unsigned)__builtin_amdgcn_readlane((int)v, 0) | (unsigned)__builtin_amdgcn_readlane((int)v, 16) | (unsigned)__builtin_amdgcn_readlane((int)v, 32) | (unsigned)__builtin_amdgcn_readlane((int)v, 48);
}
template <bool REWRITE>
__device__ __forceinline__ unsigned select_rank(LAS unsigned* qb, int n, int lane, int& newcnt, const int target, const int slack) {
    unsigned e[9]; unsigned orl = 0u, norl = 0u;
#pragma unroll
    for (int i = 0; i < 9; ++i) { const int idx = lane + 64 * i; const bool ok = idx < n; e[i] = ok ? qb[idx] : 0u; orl |= e[i]; norl |= ok ? ~e[i] : 0u; }
    const unsigned orv = wave_or_u32(orl), andv = ~wave_or_u32(norl), diff = orv ^ andv;
    const int hb = 31 - __builtin_clz(diff | 1u);
    unsigned T = andv & ~((2u << hb) - 1u); int cT = n;
    for (int bit = hb; bit >= 0; --bit) {
        const unsigned cand = T | (1u << bit); int c = 0;
#pragma unroll
        for (int i = 0; i < 9; ++i) c += __builtin_popcountll(__ballot(e[i] >= cand));
        if (c >= target) { T = cand; cT = c; if (c <= target + slack) break; }
    }
    if (REWRITE) { int base = 0;
#pragma unroll
        for (int i = 0; i < 9; ++i) { const bool keep = e[i] >= T; const unsigned long long m = __ballot(keep); if (keep) qb[base + (int)mbcnt64(m)] = e[i]; base += __builtin_popcountll(m); }
        newcnt = base; }
    else newcnt = cT;
    return T;
}
template <bool FINAL>
__device__ __forceinline__ unsigned select256(LAS unsigned* qb, int n, int lane, int& newcnt) { return select_rank<true>(qb, n, lane, newcnt, 256, FINAL ? 0 : 64); }
__device__ __forceinline__ void dsa_chunk(Frame& F, const Args& a, int b, int c) {
    unsigned char* ws = F.ws; const int lane = F.lane, wave = F.wave, hh = lane >> 5;
    LAS unsigned* wbuf = (LAS unsigned*)(F.lds + wave * (8 * CAP * 4));
    const int qbase = b * SEQ + c * 64 + 8 * wave;
    int nsel[8];
    {
        const bf16_t* QI = (const bf16_t*)(ws + WS_QIDX); const float* WI = (const float*)(ws + WS_WIDX); const bf16_t* KI = (const bf16_t*)(ws + WS_KIDX) + (size_t)b * SEQ * 64;
        bf16x8 Aq[2][4]; float wv[2][16];
        { const int r = lane & 31, j_ = r & 3, hb = (r >> 2) & 1, g = r >> 3, h = j_ + 4 * (g & 1), tq = hb + 2 * (g >> 1);
#pragma unroll
          for (int rt = 0; rt < 2; ++rt)
#pragma unroll
              for (int s = 0; s < 4; ++s) Aq[rt][s] = *(const bf16x8*)(QI + (size_t)(qbase + 4 * rt + tq) * 512 + h * 64 + 16 * s + 8 * hh);
#pragma unroll
          for (int rt = 0; rt < 2; ++rt)
#pragma unroll
              for (int gq = 0; gq < 2; ++gq) { const float* wp = WI + (size_t)(qbase + 4 * rt + hh + 2 * gq) * 8; const f32x4 w0 = *(const f32x4*)wp, w1 = *(const f32x4*)(wp + 4);
                  wv[rt][8 * gq + 0] = w0.x; wv[rt][8 * gq + 1] = w0.y; wv[rt][8 * gq + 2] = w0.z; wv[rt][8 * gq + 3] = w0.w; wv[rt][8 * gq + 4] = w1.x; wv[rt][8 * gq + 5] = w1.y; wv[rt][8 * gq + 6] = w1.z; wv[rt][8 * gq + 7] = w1.w; } }
        unsigned thr[4] = {0u, 0u, 0u, 0u}; int cntv[4] = {0, 0, 0, 0};
        const int nkt = (c + 1) * 2;
        const char* KIb = (const char*)KI;
        auto scan = [&](const int st, const int njt, const int keep) {
            bf16x8 Bq[2][4];
#pragma unroll
            for (int i = 0; i < 2; ++i) { const int kti = (i < njt ? i : njt - 1) * st;
#pragma unroll
                for (int s = 0; s < 4; ++s) Bq[i][s] = *(const bf16x8*)(KIb + (size_t)kti * 4096 + (2 * s + hh) * 512 + (lane & 31) * 16); }
            int j = 0;
#pragma unroll 1
            while (j < njt) {
                int mxc = 0;
#pragma unroll
                for (int k = 0; k < 4; ++k) { const int n0 = __builtin_amdgcn_readlane(cntv[k], 0), n1 = __builtin_amdgcn_readlane(cntv[k], 32); mxc = n0 > mxc ? n0 : mxc; mxc = n1 > mxc ? n1 : mxc; }
                const int run = ((CAP - mxc) >> 5) & ~1;
                if (run == 0) {
#pragma unroll
                    for (int k = 0; k < 4; ++k)
#pragma unroll
                        for (int hq = 0; hq < 2; ++hq) { const int n = __builtin_amdgcn_readlane(cntv[k], 32 * hq);
                            if (n > CAP - 64) { int nc; const unsigned T = select_rank<true>(wbuf + (2 * k + hq) * CAP, n, lane, nc, keep, 64);
                                if (hh == hq) { thr[k] = T - 1u; cntv[k] = nc; } } }
                    continue;
                }
                const int jend = j + run < njt ? j + run : njt;
#pragma unroll 1
                for (; j < jend; j += 2) {
#pragma unroll
                    for (int i = 0; i < 2; ++i) {
                        const int jj = j + i;
                        if (jj < jend) {
                            const int kti = jj * st;
                            const unsigned kinv = 8191u - (unsigned)(32 * kti + (lane & 31));
                            f32x16 accs[2];
#pragma unroll
                            for (int rt = 0; rt < 2; ++rt) {
#pragma unroll
                                for (int e = 0; e < 16; ++e) accs[rt][e] = 0.f;
#pragma unroll
                                for (int s = 0; s < 4; ++s) accs[rt] = __builtin_amdgcn_mfma_f32_32x32x16_bf16(Aq[rt][s], Bq[i][s], accs[rt], 0, 0, 0); }
                            asm volatile("s_nop 15" : "+v"(accs[0]), "+v"(accs[1]));
                            { const int ktn = (jj + 2 < njt ? jj + 2 : njt - 1) * st;
#pragma unroll
                              for (int s = 0; s < 4; ++s) Bq[i][s] = *(const bf16x8*)(KIb + (size_t)ktn * 4096 + (2 * s + hh) * 512 + (lane & 31) * 16); }
                            unsigned keys[4];
#pragma unroll
                            for (int rt = 0; rt < 2; ++rt) {
                                const f32x16 acc = accs[rt];
#pragma unroll
                                for (int gq = 0; gq < 2; ++gq) {
                                    float s0 = 0.f, s1 = 0.f;
#pragma unroll
                                    for (int h = 0; h < 8; h += 2) { float m0, m1; asm("v_max_f32_e32 %0, 0, %1" : "=v"(m0) : "v"(acc[8 * gq + h])); asm("v_max_f32_e32 %0, 0, %1" : "=v"(m1) : "v"(acc[8 * gq + h + 1]));
                                        s0 = __builtin_fmaf(wv[rt][8 * gq + h], m0, s0); s1 = __builtin_fmaf(wv[rt][8 * gq + h + 1], m1, s1); }
                                    const float sc = s0 + s1;
                                    const unsigned u = __builtin_bit_cast(unsigned, sc); const unsigned ord = u ^ ((unsigned)((int)u >> 31) | 0x80000000u);
                                    keys[2 * rt + gq] = (ord & 0xFFFFE000u) | kinv;
                                }
                            }
#pragma unroll
                            for (int k = 0; k < 4; ++k) {
                                const unsigned key = keys[k];
                                const bool pass = key > thr[k];
                                const unsigned long long m = __ballot(pass);
                                if (m) { const unsigned mlo = (unsigned)m, mhi = (unsigned)(m >> 32);
                                    const unsigned pre = __builtin_amdgcn_mbcnt_hi(hh ? mhi : 0u, __builtin_amdgcn_mbcnt_lo(hh ? 0u : mlo, 0u));
                                    if (pass) wbuf[(2 * k + hh) * CAP + cntv[k] + (int)pre] = key;
                                    cntv[k] += hh ? __builtin_popcount(mhi) : __builtin_popcount(mlo); }
                            }
                        }
                    }
                }
                j = jend;
            }
        };
        bool sampled = false;
        if (nkt >= 64) {
            sampled = true;
            scan(8, nkt >> 3, S1_KS);
#pragma unroll
            for (int k = 0; k < 4; ++k)
#pragma unroll
                for (int hq = 0; hq < 2; ++hq) { const int n = __builtin_amdgcn_readlane(cntv[k], 32 * hq); unsigned T = 1u;
                    if (n > S1_KS) { int nc; T = select_rank<false>(wbuf + (2 * k + hq) * CAP, n, lane, nc, S1_KS, 8); }
                    if (hh == hq) { thr[k] = T - 1u; cntv[k] = 0; } }
        }
        for (;;) {
            scan(1, nkt, 256);
            bool shortfall = false;
#pragma unroll
            for (int k = 0; k < 4; ++k)
#pragma unroll
                for (int hq = 0; hq < 2; ++hq) { int n = __builtin_amdgcn_readlane(cntv[k], 32 * hq);
                    if (n > 256) { int nc; (void)select256<true>(wbuf + (2 * k + hq) * CAP, n, lane, nc); n = nc; }
                    else if (n < 256 && sampled) shortfall = true;
                    nsel[2 * k + hq] = n; }
            if (!shortfall) break;
            sampled = false;
#pragma unroll
            for (int k = 0; k < 4; ++k) { thr[k] = 0u; cntv[k] = 0; }
        }
    }
    unsigned short* LIST = (unsigned short*)(ws + WS_LIST);
#pragma unroll
    for (int qi = 0; qi < 8; ++qi) { const int ns = nsel[qi]; const u32x4 kq = *(const LAS u32x4*)(wbuf + qi * CAP + 4 * lane);
        const unsigned i0 = 4 * lane + 0 < ns ? 8191u - (kq.x & 0x1FFFu) : 0u, i1 = 4 * lane + 1 < ns ? 8191u - (kq.y & 0x1FFFu) : 0u, i2 = 4 * lane + 2 < ns ? 8191u - (kq.z & 0x1FFFu) : 0u, i3 = 4 * lane + 3 < ns ? 8191u - (kq.w & 0x1FFFu) : 0u;
        u32x2 o; o.x = i0 | (i1 << 16); o.y = i2 | (i3 << 16);
        *(u32x2*)(LIST + (size_t)(qbase + qi) * 256 + 4 * lane) = o; }
}
__device__ __forceinline__ void dsa_phase(Frame& F, const Args& a) {
    for (int p = F.vcu; p < 256; p += F.G) { const int b = p >> 6, c0 = p & 63; dsa_chunk(F, a, b, c0); dsa_chunk(F, a, b, 127 - c0); }
}


typedef short v4i16_t __attribute__((ext_vector_type(4)));
constexpr int S2_WAVE_LDS = 17408, S2_LIST_OFF = 16384;
#define S2_WAIT(n) asm volatile("s_waitcnt vmcnt(" #n ")" ::: "memory")
__device__ __forceinline__ void dsa2_item(Frame& F, int b, int t, int j) {
    unsigned char* ws = F.ws; const int lane = F.lane, hd = lane & 15, g4 = lane >> 4;
    LAS unsigned char* wl = F.lds + F.wave * S2_WAVE_LDS;
    LAS unsigned short* lst = (LAS unsigned short*)(wl + S2_LIST_OFF);
    const size_t tq = (size_t)b * SEQ + t;
    const int nadm = ((t >> 6) + 1) * 64, ns = nadm < 256 ? nadm : 256;
    const bf16_t* Q = (const bf16_t*)(ws + WS_Q);
    const char* Kb = (const char*)(ws + WS_K8) + (size_t)b * SEQ * 256 + j * 128; const char* Vb = (const char*)(ws + WS_V8) + (size_t)b * SEQ * 256 + j * 128;
    { const u32x2 lv = *(const u32x2*)((const unsigned short*)(ws + WS_LIST) + tq * 256 + 4 * lane);
      bf16x8 qf[4];
#pragma unroll
      for (int s = 0; s < 4; ++s) qf[s] = *(const bf16x8*)(Q + tq * DM + (4 * j + (hd & 3)) * 128 + 32 * s + 8 * g4);
      S2_WAIT(0);
      *(LAS u32x2*)(lst + 4 * lane) = lv;
      asm volatile("s_waitcnt lgkmcnt(0)" ::: "memory");
      long Bq[4];
#pragma unroll
      for (int s = 0; s < 4; ++s) { const u32x4 qv = __builtin_bit_cast(u32x4, qf[s]);
          const unsigned lo = fp8x4(bflo(qv.x), bfhi(qv.x), bflo(qv.y), bfhi(qv.y)), hi = fp8x4(bflo(qv.z), bfhi(qv.z), bflo(qv.w), bfhi(qv.w));
          Bq[s] = hd < 4 ? (long)(((unsigned long long)hi << 32) | lo) : 0l; }
      const int dr8 = lane >> 3, dc8 = lane & 7;
#define S2_DMAK(g_) do { _Pragma("unroll") for (int _m = 0; _m < 2; ++_m) { const int _row = 8 * _m + dr8; const unsigned _kx = lst[16 * (g_) + _row]; \
          __builtin_amdgcn_global_load_lds((const unsigned*)(Kb + (size_t)_kx * 256 + ((dc8 ^ (_row & 7)) << 4)), (LAS unsigned*)(wl + ((g_) & 7) * 2048 + _m * 1024), 16, 0, 0); } } while (0)
      S2_DMAK(0); S2_DMAK(1); S2_DMAK(2); S2_DMAK(3); S2_DMAK(4); S2_DMAK(5);
      f32x4 sreg[16];
#pragma unroll
      for (int g = 0; g < 16; ++g) {
          if (g + 6 < 16) { S2_DMAK(g + 6); S2_WAIT(12); } else if (g == 10) { S2_WAIT(10); } else if (g == 11) { S2_WAIT(8); } else if (g == 12) { S2_WAIT(6); } else if (g == 13) { S2_WAIT(4); } else if (g == 14) { S2_WAIT(2); } else { S2_WAIT(0); }
          LAS const unsigned char* sl = wl + (g & 7) * 2048 + hd * 128 + (g4 & 1) * 8;
          f32x4 acc = (f32x4){0.f, 0.f, 0.f, 0.f};
#pragma unroll
          for (int s = 0; s < 4; ++s) { const long af = *(const LAS long*)(sl + (((2 * s + (g4 >> 1)) ^ (hd & 7)) << 4)); acc = __builtin_amdgcn_mfma_f32_16x16x32_fp8_fp8(af, Bq[s], acc, 0, 0, 0); }
          sreg[g] = acc;
      }
      if (ns < 256) {
#pragma unroll
          for (int g = 0; g < 16; ++g) if (!(16 * g < ns)) sreg[g] = (f32x4){-1e30f, -1e30f, -1e30f, -1e30f}; }
      asm volatile("s_waitcnt lgkmcnt(0)" ::: "memory");
#define S2_DMAV(g_) do { _Pragma("unroll") for (int _m = 0; _m < 2; ++_m) { const int _row = 8 * _m + dr8; const unsigned _kx = lst[16 * (g_) + _row]; \
          __builtin_amdgcn_global_load_lds((const unsigned*)(Vb + (size_t)_kx * 256 + ((dc8 ^ (_row & 7)) << 4)), (LAS unsigned*)(wl + ((g_) & 7) * 2048 + _m * 1024), 16, 0, 0); } } while (0)
      S2_DMAV(0); S2_DMAV(1); S2_DMAV(2); S2_DMAV(3); S2_DMAV(4); S2_DMAV(5);
      float mx = -1e30f;
#pragma unroll
      for (int g = 0; g < 16; ++g) mx = fmaxf(mx, fmaxf(fmaxf(sreg[g][0], sreg[g][1]), fmaxf(sreg[g][2], sreg[g][3])));
      mx = fmaxf(mx, __shfl_xor(mx, 16)); mx = fmaxf(mx, __shfl_xor(mx, 32));
      const float mxb = 8.0f - mx * QSCALE;
      float lsp[4] = {0.f, 0.f, 0.f, 0.f};
#pragma unroll
      for (int g = 0; g < 16; ++g)
#pragma unroll
          for (int e = 0; e < 4; ++e) { const float p = __builtin_amdgcn_exp2f(__builtin_fmaf(sreg[g][e], QSCALE, mxb)); sreg[g][e] = p; lsp[e] += p; }
      float ls = (lsp[0] + lsp[1]) + (lsp[2] + lsp[3]);
      ls += __shfl_xor(ls, 16); ls += __shfl_xor(ls, 32);
      f32x4 o[8];
#pragma unroll
      for (int ct = 0; ct < 8; ++ct) o[ct] = (f32x4){0.f, 0.f, 0.f, 0.f};
      const int tq_ = hd >> 1, tp = hd & 1, trow = 4 * g4 + (tq_ & 3), tsel = tq_ >> 2;
      typedef int v2i32_t __attribute__((ext_vector_type(2)));
#pragma unroll
      for (int ks = 0; ks < 8; ++ks) {
          if (ks + 3 < 8) { S2_DMAV(2 * ks + 6); S2_DMAV(2 * ks + 7); }
          if (ks <= 4) { S2_WAIT(12); } else if (ks == 5) { S2_WAIT(8); } else if (ks == 6) { S2_WAIT(4); } else { S2_WAIT(0); }
          const unsigned plo = fp8x4(sreg[2 * ks][0], sreg[2 * ks][1], sreg[2 * ks][2], sreg[2 * ks][3]), phi = fp8x4(sreg[2 * ks + 1][0], sreg[2 * ks + 1][1], sreg[2 * ks + 1][2], sreg[2 * ks + 1][3]);
          const long af = (long)(((unsigned long long)phi << 32) | plo);
          LAS const unsigned char* sV = wl + (tsel ? ((2 * ks + 1) & 7) : ((2 * ks) & 7)) * 2048 + trow * 128 + tp * 8;
#pragma unroll
          for (int ct = 0; ct < 8; ++ct) { const v2i32_t bv = __builtin_amdgcn_ds_read_tr8_b64_v2i32((LAS v2i32_t*)(sV + ((ct ^ (trow & 7)) << 4)));
              o[ct] = __builtin_amdgcn_mfma_f32_16x16x32_fp8_fp8(af, __builtin_bit_cast(long, bv), o[ct], 0, 0, 0); }
          asm volatile("s_waitcnt lgkmcnt(0)" ::: "memory");
      }
#undef S2_DMAV
#undef S2_DMAK
      float li[4];
#pragma unroll
      for (int e = 0; e < 4; ++e) li[e] = 1.0f / __shfl(ls, e);
      if (g4 == 0) { bf16_t* yb = (bf16_t*)(ws + WS_Q) + tq * DM + (4 * j) * 128 + hd;
#pragma unroll
          for (int e = 0; e < 4; ++e)
#pragma unroll
              for (int ct = 0; ct < 8; ++ct) yb[e * 128 + 16 * ct] = (bf16_t)f2bf(o[ct][e] * li[e]); }
    }
}
__device__ __forceinline__ void dsa2_phase(Frame& F, const Args& a) {
    for (int p = F.vcu; p < 256; p += F.G) { const int x = p >> 5, b = x >> 1, j = x & 1, wl_ = (p & 31) * NWAVES + F.wave;
        for (int i = 0; i < 32; ++i) dsa2_item(F, b, wl_ + 256 * i, j); }
}

__global__ void __launch_bounds__(NWAVES * 64, 2) fwd_kernel(Args args) {
    extern __shared__ __attribute__((aligned(16))) unsigned char lds[];
    Frame F;
    F.lds = (LAS unsigned char*)lds; F.MISC = (volatile LAS unsigned*)(F.lds + MISC_OFF);
    F.tid = threadIdx.x; F.lane = F.tid & 63; F.wave = __builtin_amdgcn_readfirstlane(F.tid >> 6);
    F.G = gridDim.x; { const int bx = blockIdx.x; F.vcu = (F.G % 8 == 0) ? (bx % 8) * (F.G / 8) + bx / 8 : bx; }
    F.ws = args.ws; F.ctl = (unsigned*)(args.ws + WS_CTL);
    for (int u = F.tid; u < (LDS_BYTES - LDSCTL_OFF) / 4; u += NWAVES * 64) ((LAS unsigned*)(F.lds + LDSCTL_OFF))[u] = 0u;
    __syncthreads();
    XcdBarrier bar; bar.bar = F.ctl + CW_BAR; bar.x = 0; bar.st = nullptr;
    if (MK_N_LAUNCHES == 1) bar = xcd_barrier_post(F.ctl + CW_BAR, F.MISC + 8);
#define GRID_BAR() do { if (MK_N_LAUNCHES == 1) xcd_barrier(bar); } while (0)
    const int lo = args.ph_lo, hi = args.ph_hi;
#define IN(k) (lo <= (k) && (k) < hi)
#define BOTH(k) (IN(k) && IN((k) + 1))
    unsigned char* ws = args.ws;
    if (IN(0)) { p0_prologue(F, args); if (BOTH(0)) GRID_BAR(); }
    if (IN(1)) {
        pg8::Gemm g{(const char*)(ws + WS_XN), DM * 2, DM}; pg8::DenseOrder S; S.init(NTOK, NP, DM, F.G, (int)blockIdx.x, ws + WS_WIN);
        EpiProj E{ws, (unsigned char*)args.out};
        pg8::gemm_phase(F.lds, g, S, E);
        { LAS float* scr = (LAS float*)(F.lds + F.wave * 16384); const int lane = F.lane;
          tail_items(F, (int)blockIdx.x, S.nwg % F.G, I_W13 - DEF_W13, I_W13, [&](int r) { p0_item_w13(args, ws, r, scr, lane); }); }
        if (BOTH(1)) GRID_BAR();
    }
    if (IN(2)) {
        if (F.vcu & 1) { lru_phase<0>(F, args); __syncthreads(); p2_postproj(F, args); } else { p2_postproj(F, args); __syncthreads(); lru_phase<0>(F, args); }
        if (BOTH(2)) GRID_BAR(); }
    if (IN(3)) { lru_phase<1>(F, args);
        __syncthreads(); dsa_phase(F, args);
        if (BOTH(3)) GRID_BAR(); }
    if (IN(4)) { dsa2_phase(F, args); __syncthreads(); }
    if (IN(5)) {
        pg8::Gemm g{(const char*)(ws + WS_XN), DM * 2, DM}; pg8::DenseOrder S; S.init(NTOK, DM, DM, F.G, (int)blockIdx.x, ws + WS_WA);
        EpiMerge<false> E{(const bf16_t*)args.out, 0, nullptr, (bf16_t*)(ws + WS_LRUX)};
        pg8::gemm_phase(F.lds, g, S, E);
        if (BOTH(5)) GRID_BAR();
    }
    if (IN(6)) {
        pg8::Gemm g{(const char*)(ws + WS_Q), DM * 2, DM}; pg8::DenseOrder S; S.init(NTOK, DM, DM, F.G, (int)blockIdx.x, ws + WS_WB);
        EpiMerge<true> E{(const bf16_t*)args.out, 1024, (const bf16_t*)(ws + WS_LRUX), (bf16_t*)(ws + WS_GATE)};
        pg8::gemm_phase(F.lds, g, S, E);
        if (BOTH(6)) GRID_BAR();
    }
    if (IN(7)) {
        pg8::Gemm g{(const char*)(ws + WS_GATE), DM * 2, DM}; pg8::DenseOrder S; S.init(NTOK, DM, DM, F.G, (int)blockIdx.x, ws + WS_WO);
        EpiResid E{(const float*)args.in[0], (bf16_t*)(ws + WS_XMID)};
        pg8::gemm_phase(F.lds, g, S, E);
        if (BOTH(7)) GRID_BAR();
    }
    if (IN(8)) {
        auto w13_share = [&]() { LAS float* scr = (LAS float*)(F.lds + 40960 + F.wave * 8704); const int lane = F.lane;
            for (int r = F.vcu * NWAVES + F.wave; r < I_W13 - DEF_W13; r += F.G * NWAVES) p0_item_w13(args, ws, r, scr, lane); };
        if (F.vcu & 1) { w13_share(); __syncthreads(); p7_router(F, args); } else { p7_router(F, args); w13_share(); }
        if (BOTH(8)) GRID_BAR(); }
    if (IN(9)) {
        moe_sched_setup(F);
        pg8::Gemm g{(const char*)(ws + WS_XMID), DM * 2, DM};
        GroupOrder<true> S{(LAS const int*)(F.lds + MOE_LDS_OFF), F.G, F.vcu, (const char*)(ws + WS_W13), (size_t)1024 * DM * 2, (size_t)256 * DM * 2, (const int*)(ws + WS_TOKE)};
        EpiGlu E{(bf16_t*)(ws + WS_ACT), (const float*)(ws + WS_RSTDE)};
        pg8::gemm_phase(F.lds, g, S, E);
        { LAS float* scr = (LAS float*)(F.lds + F.wave * 16384); const int lane = F.lane;
          tail_items(F, F.vcu, (4 * S.sc[64]) % F.G, 0, I_W2, [&](int r) { p0_item_w2(args, ws, r, scr, lane); }); }
        if (BOTH(9)) GRID_BAR();
    }
    if (IN(10)) {
        moe_sched_setup(F);
        pg8::Gemm g{(const char*)(ws + WS_ACT), EFF * 2, EFF};
        GroupOrder<false> S{(LAS const int*)(F.lds + MOE_LDS_OFF), F.G, F.vcu, (const char*)(ws + WS_W2), (size_t)DM * EFF * 2, (size_t)256 * EFF * 2, nullptr};
        EpiScale E{(const float*)(ws + WS_GATEE), (bf16_t*)(ws + WS_Y)};
        pg8::gemm_phase(F.lds, g, S, E);
        if (BOTH(10)) GRID_BAR();
    }
    if (IN(11)) { moe_sched_setup(F); p10_combine(F, args); }
#undef IN
#undef BOTH
}

extern "C" void kernel_launch(void* const* d_in, const int* in_sizes, int n_in, void* d_out, int out_size, void* d_ws, size_t ws_size, hipStream_t stream) {
    static int grid = 0;
    if (grid == 0) {
        if (n_in != 24 || in_sizes[0] != NTOK * DM || out_size != NTOK * DM || ws_size < WS_END) { fprintf(stderr, "kernel_launch: unexpected shapes (n_in %d, in0 %d, out %d, ws %zu)\n", n_in, n_in > 0 ? in_sizes[0] : -1, out_size, ws_size); grid = -1; return; }
        int dev = 0, cus = 0, per_cu = 0;
        if (hipGetDevice(&dev) != hipSuccess || hipDeviceGetAttribute(&cus, hipDeviceAttributeMultiprocessorCount, dev) != hipSuccess) { grid = -1; return; }
        if (hipFuncSetAttribute((const void*)fwd_kernel, hipFuncAttributeMaxDynamicSharedMemorySize, LDS_BYTES) != hipSuccess) { fprintf(stderr, "kernel_launch: hipFuncSetAttribute failed\n"); grid = -1; return; }
        if (hipOccupancyMaxActiveBlocksPerMultiprocessor(&per_cu, (const void*)fwd_kernel, NWAVES * 64, LDS_BYTES) != hipSuccess || per_cu < 1) { fprintf(stderr, "kernel_launch: occupancy query says %d\n", per_cu); per_cu = 1; }
        (void)hipGetLastError();
        grid = cus;
        if (grid > 256) grid = 256;
    }
    if (grid < 0) return;
    (void)hipMemsetAsync((char*)d_ws + WS_CTL, 0, CTL_BYTES, stream);
    Args a{};
    for (int i = 0; i < 24; ++i) a.in[i] = d_in[i];
    a.out = (float*)d_out; a.ws = (unsigned char*)d_ws;
    if (MK_N_LAUNCHES == 1) { a.ph_lo = 0; a.ph_hi = N_PHASES; hipLaunchKernelGGL(fwd_kernel, dim3(grid), dim3(NWAVES * 64), LDS_BYTES, stream, a); }
    else for (int p = 0; p < N_PHASES; ++p) { a.ph_lo = p; a.ph_hi = p + 1; hipLaunchKernelGGL(fwd_kernel, dim3(grid), dim3(NWAVES * 64), LDS_BYTES, stream, a); }
}
```

```cpp
#include <hip/hip_runtime.h>
#include <cstdio>
#include <cstdint>

#define LAS __attribute__((address_space(3)))
#define GAS __attribute__((address_space(1)))
typedef unsigned short bf16_t;
typedef short bf16x8 __attribute__((ext_vector_type(8)));
typedef float f32x4 __attribute__((ext_vector_type(4)));
typedef float f32x2 __attribute__((ext_vector_type(2)));
typedef float f32x16 __attribute__((ext_vector_type(16)));
typedef unsigned u32x4 __attribute__((ext_vector_type(4)));
typedef unsigned u32x2 __attribute__((ext_vector_type(2)));

constexpr int DM = 1024, NB = 4, SEQ = 8192, NTOK = NB * SEQ;
constexpr int NH = 8, HD = 128, NKV = 2, KVW = NKV * HD;
constexpr int IH = 8, IDIM = 64, TOPK = 256, CHUNK = 64;
constexpr int NEXP = 32, EPG = 8, NGRP = 4, EFF = 512;
constexpr int IN_COLS = 6216, NP = 6400;
constexpr int NSLOT = (NTOK * 2 / 256 + NEXP) * 256;
constexpr float NORM_EPS = 1e-6f;

constexpr size_t MiB = 1u << 20;
constexpr size_t WS_CTL = 0, CTL_BYTES = 1 * MiB;
constexpr size_t WS_WG = 1 * MiB;
constexpr size_t WS_WR = 2 * MiB;
constexpr size_t WS_WIN = 4 * MiB;
constexpr size_t WS_WA = 17 * MiB, WS_WB = 19 * MiB, WS_WO = 21 * MiB;
constexpr size_t WS_W13 = 23 * MiB;
constexpr size_t WS_W2 = 87 * MiB;
constexpr size_t WS_ROPE = 119 * MiB;
constexpr size_t WS_WIDX = 125 * MiB;
constexpr size_t WS_KIDX = 126 * MiB;
constexpr size_t WS_LSUM = 130 * MiB;
constexpr size_t WS_TOKE = 134 * MiB;
constexpr size_t WS_GATEE = 138 * MiB;
constexpr size_t WS_TINFO = 142 * MiB;
constexpr size_t WS_XN = 144 * MiB;
constexpr size_t WS_Q = 208 * MiB;
constexpr size_t WS_K = 272 * MiB, WS_V = 288 * MiB;
constexpr size_t WS_QIDX = 304 * MiB;
constexpr size_t WS_MISC = 336 * MiB;
constexpr size_t WS_LRUX = 352 * MiB;
constexpr size_t WS_GATE = 416 * MiB;
constexpr size_t WS_Y = 144 * MiB;
constexpr size_t WS_ACT = 416 * MiB;
constexpr size_t WS_LIST = 488 * MiB;
constexpr size_t WS_V8 = 480 * MiB;
constexpr size_t WS_K8 = 504 * MiB;
constexpr size_t WS_RSTDE = 119 * MiB;
constexpr size_t WS_XMID = 288 * MiB;
constexpr size_t WS_END = 512 * MiB;
static_assert(WS_ACT + (size_t)NSLOT * EFF * 2 <= WS_END && WS_Y + (size_t)NSLOT * DM * 2 <= WS_V, "ws map");

constexpr int CW_TMO = 0;
constexpr int CW_BAR = 4096;
constexpr int CW_ECNT = 16384;

#define LDS_WAIT() asm volatile("s_waitcnt lgkmcnt(0)" ::: "memory")
#define VM_WAIT() asm volatile("s_waitcnt vmcnt(0)" ::: "memory")
#define RLX_AGENT __ATOMIC_RELAXED, __HIP_MEMORY_SCOPE_AGENT
__device__ __forceinline__ unsigned f2bf(float f) { unsigned u = __builtin_bit_cast(unsigned, f); return (u + 0x7fffu + ((u >> 16) & 1u)) >> 16; }
__device__ __forceinline__ unsigned pk2(float lo, float hi) { return f2bf(lo) | (f2bf(hi) << 16); }
__device__ __forceinline__ float bf2f(unsigned short b) { return __builtin_bit_cast(float, (unsigned)b << 16); }
__device__ __forceinline__ float bflo(unsigned w) { return __builtin_bit_cast(float, w << 16); }
__device__ __forceinline__ float bfhi(unsigned w) { return __builtin_bit_cast(float, w & 0xffff0000u); }
__device__ __forceinline__ unsigned cvt_pk_bf16(float lo, float hi) { unsigned r; asm volatile("v_cvt_pk_bf16_f32 %0, %1, %2" : "=v"(r) : "v"(lo), "v"(hi)); return r; }
__device__ __forceinline__ float fast_exp(float x) { return __builtin_amdgcn_exp2f(x * 1.4426950408889634f); }
__device__ __forceinline__ float fast_rcp(float x) { return __builtin_amdgcn_rcpf(x); }
__device__ __forceinline__ float sigmoidf_(float x) { return fast_rcp(1.0f + fast_exp(-x)); }
__device__ __forceinline__ float gelu_tanh(float x) {
    const float z = 0.7978845608028654f * (x + 0.044715f * x * x * x);
    return x * sigmoidf_(2.0f * z);
}
__device__ __forceinline__ float wave_sum(float v) {
#pragma unroll
    for (int o = 1; o < 64; o <<= 1) v += __shfl_xor(v, o);
    return v;
}

namespace pg8 {
constexpr int BM = 256, BK = 64, HALF = 128, HTB = HALF * BK * 2, STAGE_BYTES = 8 * HTB;
__host__ __device__ __forceinline__ int lds_byte(int r, int c) { const int st = (r >> 4) * 2 + (c >> 5), rr = r & 15, cc = c & 31, ob = rr * 64 + cc * 2; return st * 1024 + (ob ^ (((ob >> 9) & 1) << 5)); }
__host__ __device__ __forceinline__ void stage_rc(int b, int& R, int& C) { const int st = b / 1024, sb = b % 1024, swz = sb ^ (((sb >> 9) & 1) << 5); R = (st >> 1) * 16 + swz / 64; C = (st & 1) * 32 + (swz % 64) / 2; }
__host__ __device__ __forceinline__ int perm32(int rho) { const int n = rho >> 4, i = rho & 15; return 8 * (i >> 2) + 4 * n + (i & 3); }

struct Unit { const char* B; int pm, pn, aux; };
struct Gemm { const char* A; unsigned lda; int K; };

template <class Epi, class Sched>
__device__ __forceinline__ void gemm_phase(LAS unsigned char* lds, const Gemm g, const Sched& S, const Epi& E) {
    const int tid = threadIdx.x, wid = __builtin_amdgcn_readfirstlane(tid >> 6), lane = tid & 63, wr = wid >> 2, wc = wid & 3, fr = lane & 15, fq = lane >> 4;
    const int K = g.K, nt = K / BK;
    int Rr[2]; unsigned Cb[2], voffB[2];
#pragma unroll
    for (int i = 0; i < 2; ++i) { int R, C; stage_rc(tid * 16 + i * 8192, R, C); const int Rb = Epi::PERM ? ((R & ~31) + perm32(R & 31)) : R;
        Rr[i] = R; Cb[i] = (unsigned)C * 2u; voffB[i] = (unsigned)(Rb * K + C) * 2u; }
    const size_t kstep = (size_t)(BK * 2);
    const size_t hstepB = (size_t)HALF * K * 2;
    const unsigned ldsw = (unsigned)wid * 1024u;
    const int aoff = lds_byte(wr * 64 + fr, fq * 8), boff = lds_byte(wc * 32 + fr, fq * 8);
#define PG8_SA(b, h) (((b) * 2 + (h)) * HTB)
#define PG8_SB(b, h) ((4 + (b) * 2 + (h)) * HTB)
#define PG8_STAGE(bufoff, gbase, voff) do { _Pragma("unroll") for (int _i = 0; _i < 2; ++_i) \
        __builtin_amdgcn_global_load_lds((const unsigned*)((const char*)(gbase) + (voff)[_i]), (LAS unsigned*)(lds + (bufoff) + ldsw + _i * 8192), 16, 0, 0); } while (0)
#define PG8_LDA(dst, b, h) do { _Pragma("unroll") for (int m = 0; m < 4; ++m) _Pragma("unroll") for (int k = 0; k < 2; ++k) dst[m][k] = *(const LAS bf16x8*)(lds + PG8_SA(b, h) + aoff + m * 2048 + k * 1024); } while (0)
#define PG8_LDB(dst, b, h) do { _Pragma("unroll") for (int n = 0; n < 2; ++n) _Pragma("unroll") for (int k = 0; k < 2; ++k) dst[n][k] = *(const LAS bf16x8*)(lds + PG8_SB(b, h) + boff + n * 2048 + k * 1024); } while (0)
#define PG8_MMA(ai, bj, At, Bt) do { __builtin_amdgcn_s_setprio(1); _Pragma("unroll") for (int m = 0; m < 4; ++m) _Pragma("unroll") for (int n = 0; n < 2; ++n) _Pragma("unroll") for (int k = 0; k < 2; ++k) \
        acc[ai][bj][m][n] = __builtin_amdgcn_mfma_f32_16x16x32_bf16(Bt[n][k], At[m][k], acc[ai][bj][m][n], 0, 0, 0); __builtin_amdgcn_s_setprio(0); } while (0)
#define PG8_WAIT_V(n) asm volatile("s_waitcnt vmcnt(" #n ")" ::: "memory")
#define PG8_WAIT_L(n) asm volatile("s_waitcnt lgkmcnt(" #n ")" ::: "memory")
#define PG8_BAR __builtin_amdgcn_s_barrier()
#define PG8_SCHED __builtin_amdgcn_sched_barrier(0)
#define PG8_SETVA(dst, U) do { _Pragma("unroll") for (int _h = 0; _h < 2; ++_h) _Pragma("unroll") for (int _i = 0; _i < 2; ++_i) \
        dst[_h][_i] = (unsigned)S.arow(U, _h * HALF + Rr[_i]) * g.lda + Cb[_i]; } while (0)
    Unit cur, nxt; int ui = 0;
    if (!S.next(0, cur)) return;
    f32x4 acc[2][2][4][2];
#pragma unroll
    for (int a = 0; a < 2; ++a)
#pragma unroll
        for (int b = 0; b < 2; ++b)
#pragma unroll
            for (int m = 0; m < 4; ++m)
#pragma unroll
                for (int n = 0; n < 2; ++n) acc[a][b][m][n] = (f32x4){0.f, 0.f, 0.f, 0.f};
    bf16x8 At[4][2], B0[2][2], B1[2][2];
    unsigned vAc[2][2], vAn[2][2];
    PG8_SETVA(vAc, cur);
    const char* const gA = g.A;
    const char* cB = cur.B;
    PG8_STAGE(PG8_SB(0, 0), cB, voffB); PG8_STAGE(PG8_SB(0, 1), cB + hstepB, voffB); PG8_STAGE(PG8_SA(0, 0), gA, vAc[0]); PG8_STAGE(PG8_SA(0, 1), gA, vAc[1]);
    if (wr == 1) PG8_BAR;
    PG8_WAIT_V(2); PG8_BAR;
    PG8_STAGE(PG8_SB(1, 0), cB + kstep, voffB); PG8_STAGE(PG8_SA(1, 0), gA + kstep, vAc[0]); PG8_STAGE(PG8_SB(1, 1), cB + hstepB + kstep, voffB);
    PG8_WAIT_V(6); PG8_BAR;
    for (;;) {
        const bool has_next = S.next(ui + 1, nxt);
        if (has_next) { PG8_SETVA(vAn, nxt); } else { vAn[0][0] = vAc[0][0]; vAn[0][1] = vAc[0][1]; vAn[1][0] = vAc[1][0]; vAn[1][1] = vAc[1][1]; }
        const char* nB = has_next ? nxt.B : cB;
        for (int t = 0; t < nt; t += 2) {
            const bool last = (t == nt - 2);
            const char* a1 = gA + (size_t)(t + 1) * kstep;
            const char* a2 = gA + (size_t)(last ? 0 : (t + 2)) * kstep; const char* b2 = last ? nB : cB + (size_t)(t + 2) * kstep;
            const char* a3 = a2 + kstep; const char* b3 = b2 + kstep;
            unsigned v2[2][2];
            v2[0][0] = last ? vAn[0][0] : vAc[0][0]; v2[0][1] = last ? vAn[0][1] : vAc[0][1]; v2[1][0] = last ? vAn[1][0] : vAc[1][0]; v2[1][1] = last ? vAn[1][1] : vAc[1][1];
            PG8_LDB(B0, 0, 0); PG8_LDB(B1, 0, 1); PG8_SCHED; PG8_LDA(At, 0, 0); PG8_STAGE(PG8_SA(1, 1), a1, vAc[1]);
            PG8_WAIT_V(8); PG8_WAIT_L(0); PG8_BAR; PG8_MMA(0, 0, At, B0); PG8_MMA(0, 1, At, B1); PG8_BAR; PG8_SCHED;
            PG8_LDA(At, 0, 1); PG8_STAGE(PG8_SB(0, 0), b2, voffB); PG8_STAGE(PG8_SB(0, 1), b2 + hstepB, voffB); PG8_STAGE(PG8_SA(0, 0), a2, v2[0]);
            PG8_WAIT_V(8); PG8_WAIT_L(0); PG8_BAR; PG8_MMA(1, 0, At, B0); PG8_MMA(1, 1, At, B1); PG8_BAR; PG8_SCHED;
            PG8_LDB(B0, 1, 0); PG8_LDB(B1, 1, 1); PG8_SCHED; PG8_LDA(At, 1, 0); PG8_STAGE(PG8_SA(0, 1), a2, v2[1]);
            PG8_WAIT_V(8); PG8_WAIT_L(0); PG8_BAR; PG8_MMA(0, 0, At, B0); PG8_MMA(0, 1, At, B1); PG8_BAR; PG8_SCHED;
            PG8_LDA(At, 1, 1); PG8_STAGE(PG8_SB(1, 0), b3, voffB); PG8_STAGE(PG8_SB(1, 1), b3 + hstepB, voffB); PG8_STAGE(PG8_SA(1, 0), a3, v2[0]);
            PG8_WAIT_V(8); PG8_WAIT_L(0); PG8_BAR; PG8_MMA(1, 0, At, B0); PG8_MMA(1, 1, At, B1); PG8_BAR; PG8_SCHED;
        }
        if (wr == 0) PG8_BAR;
        E(acc, cur, wr, wc, fr, fq);
        if (!has_next) break;
#pragma unroll
        for (int a = 0; a < 2; ++a)
#pragma unroll
            for (int b = 0; b < 2; ++b)
#pragma unroll
                for (int m = 0; m < 4; ++m)
#pragma unroll
                    for (int n = 0; n < 2; ++n) acc[a][b][m][n] = (f32x4){0.f, 0.f, 0.f, 0.f};
        cur = nxt; cB = nB; ++ui;
        vAc[0][0] = vAn[0][0]; vAc[0][1] = vAn[0][1]; vAc[1][0] = vAn[1][0]; vAc[1][1] = vAn[1][1];
        if (wr == 1) PG8_BAR;
    }
    PG8_WAIT_V(0);
    PG8_BAR;
#undef PG8_SA
#undef PG8_SB
#undef PG8_STAGE
#undef PG8_LDA
#undef PG8_LDB
#undef PG8_MMA
#undef PG8_WAIT_V
#undef PG8_WAIT_L
#undef PG8_BAR
#undef PG8_SCHED
#undef PG8_SETVA
}

struct DenseOrder {
    int nM, nN, nwg, G, c; const char* Bt; size_t tstepB;
    __device__ void init(int M, int N, int K, int G_, int c_, const void* Bt_) { nM = M / BM; nN = N / BM; nwg = nM * nN; G = G_; c = c_; Bt = (const char*)Bt_; tstepB = (size_t)BM * K * 2; }
    __device__ __forceinline__ bool next(int i, Unit& u) const {
        const long L = (long)i * G + c; if (L >= nwg) return false;
        int wgid = (int)L; { const int q = nwg / 8, r = nwg % 8, xcd = wgid % 8, off = wgid / 8; wgid = (xcd < r ? xcd * (q + 1) : r * (q + 1) + (xcd - r) * q) + off; }
        const int nig = 8 * nN, gid = wgid / nig, fm = gid * 8, gsz = (nM - fm) < 8 ? (nM - fm) : 8;
        u.pm = fm + ((wgid % nig) % gsz); u.pn = (wgid % nig) / gsz; u.aux = 0; u.B = Bt + (size_t)u.pn * tstepB; return true;
    }
    __device__ __forceinline__ int arow(const Unit& u, int r) const { return u.pm * BM + r; }
};
}

using pg8::Unit;
struct EpiProj {
    static constexpr bool PERM = true;
    unsigned char* ws; unsigned char* dout;
    __device__ __forceinline__ void operator()(const f32x4 (&acc)[2][2][4][2], const Unit& u, int wr, int wc, int fr, int fq) const {
        const int pn = u.pn; bf16_t* base; int ldc, colt, act = 0;
        if (pn < 4)       { base = (bf16_t*)(ws + WS_LRUX); ldc = DM;   colt = pn * 256; }
        else if (pn < 8)  { base = (bf16_t*)(ws + WS_GATE); ldc = DM;   colt = (pn - 4) * 256; act = 1; }
        else if (pn < 12) { base = (bf16_t*)(ws + WS_Q);    ldc = DM;   colt = (pn - 8) * 256; }
        else if (pn == 12){ base = (bf16_t*)(ws + WS_K);    ldc = KVW;  colt = 0; }
        else if (pn == 13){ base = (bf16_t*)(ws + WS_V);    ldc = KVW;  colt = 0; }
        else if (pn < 16) { base = (bf16_t*)(ws + WS_QIDX); ldc = 512;  colt = (pn - 14) * 256; }
        else if (pn < 24) { base = (bf16_t*)dout;           ldc = 2048; colt = (pn - 16) * 256; act = 2; }
        else              { base = (bf16_t*)(ws + WS_MISC); ldc = 256;  colt = 0; }
        const int row0 = u.pm * 256 + wr * 64 + fr, col0 = colt + wc * 32 + 8 * fq;
#pragma unroll
        for (int ai = 0; ai < 2; ++ai)
#pragma unroll
            for (int m = 0; m < 4; ++m) { bf16_t* rowp = base + (size_t)(row0 + ai * 128 + m * 16) * ldc + col0;
#pragma unroll
                for (int bj = 0; bj < 2; ++bj) { f32x4 v0 = acc[ai][bj][m][0], v1 = acc[ai][bj][m][1];
                    if (act == 1) {
#pragma unroll
                        for (int e = 0; e < 4; ++e) { v0[e] = gelu_tanh(v0[e]); v1[e] = gelu_tanh(v1[e]); } }
                    else if (act == 2) {
#pragma unroll
                        for (int e = 0; e < 4; ++e) { v0[e] = sigmoidf_(v0[e]); v1[e] = sigmoidf_(v1[e]); } }
                    u32x4 w; w.x = cvt_pk_bf16(v0[0], v0[1]); w.y = cvt_pk_bf16(v0[2], v0[3]); w.z = cvt_pk_bf16(v1[0], v1[1]); w.w = cvt_pk_bf16(v1[2], v1[3]);
                    *(u32x4*)(rowp + bj * 128) = w; } }
    }
};
template <bool ADD> struct EpiMerge {
    static constexpr bool PERM = true;
    const bf16_t* sig; int sigoff; const bf16_t* prev; bf16_t* O;
    __device__ __forceinline__ void operator()(const f32x4 (&acc)[2][2][4][2], const Unit& u, int wr, int wc, int fr, int fq) const {
        const int row0 = u.pm * 256 + wr * 64 + fr, col0 = u.pn * 256 + wc * 32 + 8 * fq;
#pragma unroll
        for (int ai = 0; ai < 2; ++ai)
#pragma unroll
            for (int m = 0; m < 4; ++m) { const size_t row = (size_t)(row0 + ai * 128 + m * 16);
#pragma unroll
                for (int bj = 0; bj < 2; ++bj) { const int col = col0 + bj * 128;
                    const u32x4 sg = *(const u32x4*)(sig + row * 2048 + sigoff + col);
                    f32x4 v0 = acc[ai][bj][m][0], v1 = acc[ai][bj][m][1];
                    v0[0] *= bflo(sg.x); v0[1] *= bfhi(sg.x); v0[2] *= bflo(sg.y); v0[3] *= bfhi(sg.y);
                    v1[0] *= bflo(sg.z); v1[1] *= bfhi(sg.z); v1[2] *= bflo(sg.w); v1[3] *= bfhi(sg.w);
                    if (ADD) { const u32x4 pv = *(const u32x4*)(prev + row * DM + col);
                        v0[0] += bflo(pv.x); v0[1] += bfhi(pv.x); v0[2] += bflo(pv.y); v0[3] += bfhi(pv.y);
                        v1[0] += bflo(pv.z); v1[1] += bfhi(pv.z); v1[2] += bflo(pv.w); v1[3] += bfhi(pv.w); }
                    u32x4 w; w.x = cvt_pk_bf16(v0[0], v0[1]); w.y = cvt_pk_bf16(v0[2], v0[3]); w.z = cvt_pk_bf16(v1[0], v1[1]); w.w = cvt_pk_bf16(v1[2], v1[3]);
                    *(u32x4*)(O + row * DM + col) = w; } }
    }
};
struct EpiResid {
    static constexpr bool PERM = true;
    const float* x; bf16_t* xmid;
    __device__ __forceinline__ void operator()(const f32x4 (&acc)[2][2][4][2], const Unit& u, int wr, int wc, int fr, int fq) const {
        const int row0 = u.pm * 256 + wr * 64 + fr, col0 = u.pn * 256 + wc * 32 + 8 * fq;
#pragma unroll
        for (int ai = 0; ai < 2; ++ai)
#pragma unroll
            for (int m = 0; m < 4; ++m) { const size_t off = (size_t)(row0 + ai * 128 + m * 16) * DM + col0;
#pragma unroll
                for (int bj = 0; bj < 2; ++bj) { const f32x4 x0 = *(const f32x4*)(x + off + bj * 128), x1 = *(const f32x4*)(x + off + bj * 128 + 4);
                    const f32x4 v0 = x0 + acc[ai][bj][m][0], v1 = x1 + acc[ai][bj][m][1];
                    u32x4 w; w.x = cvt_pk_bf16(v0[0], v0[1]); w.y = cvt_pk_bf16(v0[2], v0[3]); w.z = cvt_pk_bf16(v1[0], v1[1]); w.w = cvt_pk_bf16(v1[2], v1[3]);
                    *(u32x4*)(xmid + off + bj * 128) = w; } }
    }
};
struct EpiGlu {
    static constexpr bool PERM = true;
    bf16_t* act; const float* rstdE;
    __device__ __forceinline__ void operator()(const f32x4 (&acc)[2][2][4][2], const Unit& u, int wr, int wc, int fr, int fq) const {
        const int row0 = u.pm * 256 + wr * 64 + fr, col0 = u.pn * 128 + wc * 32 + 8 * fq;
        const float* rp = rstdE + (size_t)(u.aux >> 7) * NTOK + (u.aux & 127) * 256 + wr * 64 + fr;
#pragma unroll
        for (int ai = 0; ai < 2; ++ai)
#pragma unroll
            for (int m = 0; m < 4; ++m) { const size_t row = (size_t)(row0 + ai * 128 + m * 16); const float rs = rp[ai * 128 + m * 16];
                f32x4 v0, v1;
#pragma unroll
                for (int e = 0; e < 4; ++e) { const float g0 = acc[ai][0][m][0][e] * rs, g1 = acc[ai][0][m][1][e] * rs;
                    v0[e] = g0 * sigmoidf_(g0) * (acc[ai][1][m][0][e] * rs); v1[e] = g1 * sigmoidf_(g1) * (acc[ai][1][m][1][e] * rs); }
                u32x4 w; w.x = cvt_pk_bf16(v0[0], v0[1]); w.y = cvt_pk_bf16(v0[2], v0[3]); w.z = cvt_pk_bf16(v1[0], v1[1]); w.w = cvt_pk_bf16(v1[2], v1[3]);
                *(u32x4*)(act + row * EFF + col0) = w; }
    }
};
struct EpiScale {
    static constexpr bool PERM = true;
    const float* gateE; bf16_t* y;
    __device__ __forceinline__ void operator()(const f32x4 (&acc)[2][2][4][2], const Unit& u, int wr, int wc, int fr, int fq) const {
        const int e = u.aux >> 7, j = u.aux & 127;
        const float* gp = gateE + (size_t)e * NTOK + j * 256;
        const int rl0 = wr * 64 + fr, col0 = u.pn * 256 + wc * 32 + 8 * fq;
#pragma unroll
        for (int ai = 0; ai < 2; ++ai)
#pragma unroll
            for (int m = 0; m < 4; ++m) { const int rl = rl0 + ai * 128 + m * 16; const float gt = gp[rl]; const size_t row = (size_t)(u.pm * 256 + rl);
#pragma unroll
                for (int bj = 0; bj < 2; ++bj) { const f32x4 v0 = acc[ai][bj][m][0] * gt, v1 = acc[ai][bj][m][1] * gt;
                    u32x4 w; w.x = cvt_pk_bf16(v0[0], v0[1]); w.y = cvt_pk_bf16(v0[2], v0[3]); w.z = cvt_pk_bf16(v1[0], v1[1]); w.w = cvt_pk_bf16(v1[2], v1[3]);
                    *(u32x4*)(y + row * DM + col0 + bj * 128) = w; } }
    }
};

typedef GAS unsigned gu32;
#define XB_TMO      128
#define XB_XCNT(j)  (256  + 64 * (j))
#define XB_XSUB(j)  (1280 + 64 * (j))
#define XB_XGEN(j)  (2304 + 64 * (j))
#define XB_TOP      3328
#define XB_TOPGEN   3392
#define XCD_BAR_WORDS 3456
#define XB_SPIN_CAP (1u << 18)
__device__ __forceinline__ unsigned xb_ld(unsigned* p)              { return __hip_atomic_load(p, __ATOMIC_RELAXED, __HIP_MEMORY_SCOPE_AGENT); }
__device__ __forceinline__ unsigned xb_add(unsigned* p, unsigned v) { return __hip_atomic_fetch_add(p, v, __ATOMIC_RELAXED, __HIP_MEMORY_SCOPE_AGENT); }
__device__ __forceinline__ unsigned xb_xcc_id() { return (unsigned)__builtin_amdgcn_s_getreg((3 << 11) | 20) & 0xFu; }
#define XB_SPIN(cond, bar) do { unsigned _sp = 0; while (cond) { __builtin_amdgcn_s_sleep(1); \
    if ((++_sp & 255u) == 0u) { if (xb_ld(&(bar)[XB_TMO])) break; if (_sp > XB_SPIN_CAP) { atomicAdd(&(bar)[XB_TMO], 1u); break; } } } } while (0)
struct XcdBarrier { unsigned* bar; unsigned x; volatile LAS unsigned* st; };
__device__ __forceinline__ XcdBarrier xcd_barrier_post(unsigned* bar, volatile LAS unsigned* st) {
    XcdBarrier b; b.bar = bar; b.x = xb_xcc_id(); b.st = st;
    if (threadIdx.x == 0) (void)xb_add(&bar[XB_XCNT(b.x)], 1u);
    return b;
}
__device__ __forceinline__ void xcd_barrier_complete(unsigned* bar, unsigned x, unsigned& nloc, unsigned& nx) {
    const unsigned G = gridDim.x * gridDim.y * gridDim.z;
    unsigned sum, cnt, mine, sp = 0u;
    for (;;) {
        sum = 0u; cnt = 0u; mine = 0u;
#pragma unroll
        for (unsigned j = 0; j < 16; ++j) { const unsigned c = xb_ld(&bar[XB_XCNT(j)]); sum += c; cnt += (c > 0u) ? 1u : 0u; mine = (j == x) ? c : mine; }
        if (sum == G) break;
        __builtin_amdgcn_s_sleep(1);
        if ((++sp & 255u) == 0u) { if (xb_ld(&bar[XB_TMO])) break; if (sp > XB_SPIN_CAP) { atomicAdd(&bar[XB_TMO], 1u); break; } }
    }
    nloc = mine > 0u ? mine : 1u; nx = cnt > 0u ? cnt : 1u;
}
__device__ __forceinline__ void xcd_barrier(const XcdBarrier& b) {
    asm volatile("s_waitcnt vmcnt(0)" ::: "memory");
    __syncthreads();
    if (threadIdx.x == 0) {
        unsigned* bar = b.bar;
        __builtin_amdgcn_s_waitcnt(0);
        unsigned nloc = b.st[0], nx = b.st[1];
        if (nloc == 0u) { xcd_barrier_complete(bar, b.x, nloc, nx); b.st[0] = nloc; b.st[1] = nx; }
        const unsigned old = xb_add(&bar[XB_XSUB(b.x)], 1u);
        const unsigned gen = old / nloc;
        if (old + 1u == (gen + 1u) * nloc) {
            __builtin_amdgcn_fence(__ATOMIC_RELEASE, "agent");
            asm volatile("s_waitcnt vmcnt(0)" ::: "memory");
            const unsigned og = xb_add(&bar[XB_TOP], 1u);
            const unsigned tg = og / nx;
            if (og + 1u == (tg + 1u) * nx) xb_add(&bar[XB_TOPGEN], 1u);
            else XB_SPIN(xb_ld(&bar[XB_TOPGEN]) == tg, bar);
            __builtin_amdgcn_fence(__ATOMIC_ACQUIRE, "agent");
            xb_add(&bar[XB_XGEN(b.x)], 1u);
            asm volatile("s_waitcnt vmcnt(0)" ::: "memory");
        } else {
            XB_SPIN(xb_ld(&bar[XB_XGEN(b.x)]) == gen, bar);
            __builtin_amdgcn_fence(__ATOMIC_ACQUIRE, "agent");
            asm volatile("s_waitcnt vmcnt(0)" ::: "memory");
        }
    }
    __syncthreads();
}

constexpr int NWAVES = 8;
constexpr int RING_BYTES = 131072, LDSCTL_OFF = 147456, MISC_OFF = LDSCTL_OFF + 320, LDS_BYTES = 151552;
constexpr int N_PHASES = 12;
#ifndef MK_N_LAUNCHES
#define MK_N_LAUNCHES 1
#endif
struct Args { const void* in[24]; float* out; unsigned char* ws; int ph_lo, ph_hi; };
struct Frame {
    LAS unsigned char* lds; volatile LAS unsigned* MISC; unsigned* ctl; unsigned char* ws;
    int tid, lane, wave, vcu, G;
};

template <class CMap>
__device__ __forceinline__ void p0_transpose_item(const float* W, int ldw, bf16_t* WT, int Kd, LAS float* scr, int kb, int nb, int lane, const CMap& cmap, const float* ksc = nullptr) {
    const int k0 = 64 * kb, n0 = 32 * nb;
    const int kr = lane >> 3, nq = lane & 7; const int sc = cmap(n0 + 4 * nq);
    f32x4 v[8];
#pragma unroll
    for (int i = 0; i < 8; ++i) v[i] = sc >= 0 ? *(const f32x4*)(W + (size_t)(k0 + 8 * i + kr) * ldw + sc) : (f32x4){0.f, 0.f, 0.f, 0.f};
#pragma unroll
    for (int i = 0; i < 8; ++i) { LAS float* d = scr + (8 * i + kr) * 33 + 4 * nq; d[0] = v[i].x; d[1] = v[i].y; d[2] = v[i].z; d[3] = v[i].w; }
    LDS_WAIT(); asm volatile("" ::: "memory");
    const int c = lane & 7;
    f32x4 g0 = (f32x4){1.f, 1.f, 1.f, 1.f}, g1 = g0;
    if (ksc) { g0 = *(const f32x4*)(ksc + k0 + 8 * c); g1 = *(const f32x4*)(ksc + k0 + 8 * c + 4); }
#pragma unroll
    for (int j = 0; j < 4; ++j) { const int n = (lane >> 3) + 8 * j; const LAS float* s = scr + (8 * c) * 33 + n;
        u32x4 o; o.x = pk2(s[0 * 33] * g0.x, s[1 * 33] * g0.y); o.y = pk2(s[2 * 33] * g0.z, s[3 * 33] * g0.w); o.z = pk2(s[4 * 33] * g1.x, s[5 * 33] * g1.y); o.w = pk2(s[6 * 33] * g1.z, s[7 * 33] * g1.w);
        *(GAS u32x4*)(WT + (size_t)(n0 + n) * Kd + k0 + 8 * c) = o; }
    LDS_WAIT(); asm volatile("" ::: "memory");
}
struct CMapId { __device__ __forceinline__ int operator()(int n) const { return n; } };
struct CMapWin {
    __device__ __forceinline__ int operator()(int n) const { return n < 4096 ? n : n < 6144 ? 4168 + (n - 4096) : n < 6208 ? 4096 + (n - 6144) : n < 6216 ? 4160 + (n - 6208) : -1; } };
struct CMapW13 {
    __device__ __forceinline__ int operator()(int n) const { const int pn = n >> 8, bj = (n >> 7) & 1, j = n & 127; return 512 * bj + 128 * pn + j; } };

constexpr int I_WIN = 16 * (NP / 32), I_SQ = 16 * 32, I_W13 = 32 * 16 * 32, I_W2 = 32 * 8 * 32, I_G = 16 * 2 * 4;
constexpr int DEF_W13 = 5120;
__device__ __forceinline__ void p0_item_w13(const Args& a, unsigned char* ws, int r, LAS float* scr, int lane) {
    const int e = r / 512, q = r % 512;
    p0_transpose_item((const float*)a.in[22] + (size_t)e * DM * 1024, 1024, (bf16_t*)(ws + WS_W13) + (size_t)e * 1024 * DM, DM, scr, q / 32, q % 32, lane, CMapW13(), (const float*)a.in[17]);
}
__device__ __forceinline__ void p0_item_w2(const Args& a, unsigned char* ws, int r, LAS float* scr, int lane) {
    const int e = r / 256, q = r % 256;
    p0_transpose_item((const float*)a.in[23] + (size_t)e * EFF * DM, DM, (bf16_t*)(ws + WS_W2) + (size_t)e * DM * EFF, EFF, scr, q / 32, q % 32, lane, CMapId());
}
template <class Fn> __device__ __forceinline__ void tail_items(const Frame& F, int c, int rem, int lo, int hi, const Fn& fn) {
    const int nid = rem ? F.G - rem : F.G, idx = rem ? c - rem : c;
    if (idx < 0) return;
    for (int r = lo + idx * NWAVES + F.wave; r < hi; r += nid * NWAVES) fn(r);
}
__device__ __forceinline__ void p0_prologue(Frame& F, const Args& a) {
    LAS float* scr = (LAS float*)(F.lds + F.wave * 16384);
    const int gw = F.vcu * NWAVES + F.wave, NGW = F.G * NWAVES, lane = F.lane;
    unsigned char* ws = F.ws;
    constexpr int NITEMS = I_WIN + 3 * I_SQ + I_G;
    for (int it = gw; it < NITEMS; it += NGW) {
        int r = it;
        if (r < I_WIN) { p0_transpose_item((const float*)a.in[3], IN_COLS, (bf16_t*)(ws + WS_WIN), DM, scr, r / (NP / 32), r % (NP / 32), lane, CMapWin()); continue; } r -= I_WIN;
        if (r < I_SQ) { p0_transpose_item((const float*)a.in[14], DM, (bf16_t*)(ws + WS_WA), DM, scr, r / 32, r % 32, lane, CMapId()); continue; } r -= I_SQ;
        if (r < I_SQ) { p0_transpose_item((const float*)a.in[15], DM, (bf16_t*)(ws + WS_WB), DM, scr, r / 32, r % 32, lane, CMapId()); continue; } r -= I_SQ;
        if (r < I_SQ) { p0_transpose_item((const float*)a.in[16], DM, (bf16_t*)(ws + WS_WO), DM, scr, r / 32, r % 32, lane, CMapId()); continue; } r -= I_SQ;
        { const int blk = r >> 3, q = r & 7, gate = blk & 1, n = blk >> 1;
          const float* src = (const float*)(gate ? a.in[8] : a.in[6]) + (size_t)n * 128 * 128;
          p0_transpose_item(src, 128, (bf16_t*)(ws + WS_WG) + (size_t)blk * 128 * 128, 128, scr, q >> 2, q & 3, lane, CMapId()); }
    }
    const float* x = (const float*)a.in[0]; const float* g1 = (const float*)a.in[2];
    f32x4 gv[4];
#pragma unroll
    for (int j = 0; j < 4; ++j) gv[j] = ((const f32x4*)g1)[lane + 64 * j];
    if (gw < NTOK) {
        f32x4 v[4];
#pragma unroll
        for (int j = 0; j < 4; ++j) v[j] = ((const GAS f32x4*)(x + (size_t)gw * DM) + lane)[64 * j];
        for (int m = gw; m < NTOK; m += NGW) {
            const int mn = m + NGW < NTOK ? m + NGW : m; f32x4 vn[4];
#pragma unroll
            for (int j = 0; j < 4; ++j) vn[j] = ((const GAS f32x4*)(x + (size_t)mn * DM) + lane)[64 * j];
            float s = 0.f;
#pragma unroll
            for (int j = 0; j < 4; ++j) s += (v[j].x * v[j].x + v[j].y * v[j].y) + (v[j].z * v[j].z + v[j].w * v[j].w);
            const float rstd = 1.0f / sqrtf(wave_sum(s) * (1.f / DM) + NORM_EPS);
            GAS u32x2* o8 = (GAS u32x2*)((bf16_t*)(ws + WS_XN) + (size_t)m * DM) + lane;
#pragma unroll
            for (int j = 0; j < 4; ++j) { u32x2 o; o.x = pk2(v[j].x * rstd * gv[j].x, v[j].y * rstd * gv[j].y); o.y = pk2(v[j].z * rstd * gv[j].z, v[j].w * rstd * gv[j].w); o8[64 * j] = o; }
#pragma unroll
            for (int j = 0; j < 4; ++j) v[j] = vn[j];
        }
    }
    { const int* pos = (const int*)a.in[1]; float* rope = (float*)(ws + WS_ROPE);
      const int gt = (F.vcu * NWAVES + F.wave) * 64 + lane, NGT = NGW * 64;
      for (int i = gt; i < NTOK * 24; i += NGT) { const int t = i / 24, f = i % 24; const float p = (float)pos[t];
          if (f < 16) { const float inv = powf(500000.0f, -(float)(2 * f) / 32.0f); const float ang = p * inv; rope[(size_t)t * 16 + f] = cosf(ang); rope[(size_t)NTOK * 16 + (size_t)t * 16 + f] = sinf(ang); }
          else { const int f2 = f - 16; const float inv = powf(500000.0f, -(float)(2 * f2) / 16.0f); const float ang = p * inv; rope[(size_t)NTOK * 32 + (size_t)t * 8 + f2] = cosf(ang); rope[(size_t)NTOK * 40 + (size_t)t * 8 + f2] = sinf(ang); } }
      const float* g2 = (const float*)a.in[17]; const float* wg = (const float*)a.in[18]; const float* we = (const float*)a.in[20]; float* wrt = (float*)(ws + WS_WR);
      for (int i = gt; i < 36 * DM; i += NGT) { const int c = i / DM, k = i % DM; wrt[i] = g2[k] * (c < 4 ? wg[k * 4 + c] : we[k * 32 + (c - 4)]); } }
}

template <int EPL, bool NORM>
__device__ __forceinline__ void norm_rope_regs(float (&x)[EPL], const float* g, const float (&cs)[EPL], const float (&sn)[EPL], float scale, int lane) {
    const int hl = lane & 7;
    if (NORM) { float ss = 0.f;
#pragma unroll
        for (int e = 0; e < EPL; ++e) ss += x[e] * x[e];
        ss += __shfl_xor(ss, 1); ss += __shfl_xor(ss, 2); ss += __shfl_xor(ss, 4);
        const float rstd = 1.0f / sqrtf(ss * (1.0f / (8 * EPL)) + NORM_EPS);
#pragma unroll
        for (int e = 0; e < EPL; e += 4) { const f32x4 gv = *(const f32x4*)(g + hl * EPL + e); x[e] *= rstd * gv.x; x[e + 1] *= rstd * gv.y; x[e + 2] *= rstd * gv.z; x[e + 3] *= rstd * gv.w; } }
#pragma unroll
    for (int e = 0; e < EPL; ++e) { const float p = __shfl_xor(x[e], 1); const float c = cs[e], sv = sn[e];
        const float r0 = x[e] * c - p * sv, r1 = x[e] * c + p * sv; x[e] = (hl == 0 ? r0 : hl == 1 ? r1 : x[e]) * scale; }
}
__device__ __forceinline__ unsigned fp8x4(float a, float b, float c, float d) { int r = __builtin_amdgcn_cvt_pk_fp8_f32(a, b, 0, false); r = __builtin_amdgcn_cvt_pk_fp8_f32(c, d, r, true); return (unsigned)r; }
__device__ __forceinline__ void unpk8(const u32x4 a, float* x) { x[0] = bflo(a.x); x[1] = bfhi(a.x); x[2] = bflo(a.y); x[3] = bfhi(a.y); x[4] = bflo(a.z); x[5] = bfhi(a.z); x[6] = bflo(a.w); x[7] = bfhi(a.w); }
__device__ __forceinline__ u32x4 pk8(const float* x) { u32x4 a; a.x = pk2(x[0], x[1]); a.y = pk2(x[2], x[3]); a.z = pk2(x[4], x[5]); a.w = pk2(x[6], x[7]); return a; }
constexpr float QSCALE = 0.08838834764831845f * 1.4426950408889634f;
struct PPTok { u32x4 q0, q1, k0, k1, v0, v1, qi, ki; f32x4 cm[4], sm[4], ci[2], si[2]; unsigned wr; };
__device__ __forceinline__ void pp_load(PPTok& T, unsigned char* ws, int t, int lane) {
    const float* rope = (const float*)(ws + WS_ROPE);
    const bf16_t* q = (const bf16_t*)(ws + WS_Q) + (size_t)t * DM + lane * 16; T.q0 = *(const u32x4*)q; T.q1 = *(const u32x4*)(q + 8);
    const bf16_t* k = (const bf16_t*)(ws + WS_K) + (size_t)t * KVW + (lane & 15) * 16; T.k0 = *(const u32x4*)k; T.k1 = *(const u32x4*)(k + 8);
    const bf16_t* v = (const bf16_t*)(ws + WS_V) + (size_t)t * KVW + (lane & 15) * 16; T.v0 = *(const u32x4*)v; T.v1 = *(const u32x4*)(v + 8);
    T.qi = *(const u32x4*)((const bf16_t*)(ws + WS_QIDX) + (size_t)t * 512 + lane * 8);
    const bf16_t* ms = (const bf16_t*)(ws + WS_MISC) + (size_t)t * 256; T.ki = *(const u32x4*)(ms + (lane & 7) * 8); T.wr = ms[64 + (lane & 7)];
#pragma unroll
    for (int i = 0; i < 4; ++i) { T.cm[i] = *(const f32x4*)(rope + (size_t)t * 16 + 4 * i); T.sm[i] = *(const f32x4*)(rope + (size_t)NTOK * 16 + (size_t)t * 16 + 4 * i); }
#pragma unroll
    for (int i = 0; i < 2; ++i) { T.ci[i] = *(const f32x4*)(rope + (size_t)NTOK * 32 + (size_t)t * 8 + 4 * i); T.si[i] = *(const f32x4*)(rope + (size_t)NTOK * 40 + (size_t)t * 8 + 4 * i); }
}
__device__ __forceinline__ void pp_finish(const PPTok& T, unsigned char* ws, const Args& a, int t, int lane) {
    const float* qg = (const float*)a.in[11]; const float* kg = (const float*)a.in[12]; const float* ig = (const float*)a.in[13];
    float cm[16], sm[16], ci[8], si[8];
#pragma unroll
    for (int i = 0; i < 4; ++i) { cm[4 * i] = T.cm[i].x; cm[4 * i + 1] = T.cm[i].y; cm[4 * i + 2] = T.cm[i].z; cm[4 * i + 3] = T.cm[i].w; sm[4 * i] = T.sm[i].x; sm[4 * i + 1] = T.sm[i].y; sm[4 * i + 2] = T.sm[i].z; sm[4 * i + 3] = T.sm[i].w; }
#pragma unroll
    for (int i = 0; i < 2; ++i) { ci[4 * i] = T.ci[i].x; ci[4 * i + 1] = T.ci[i].y; ci[4 * i + 2] = T.ci[i].z; ci[4 * i + 3] = T.ci[i].w; si[4 * i] = T.si[i].x; si[4 * i + 1] = T.si[i].y; si[4 * i + 2] = T.si[i].z; si[4 * i + 3] = T.si[i].w; }
    { float x[16]; unpk8(T.q0, x); unpk8(T.q1, x + 8); norm_rope_regs<16, true>(x, qg, cm, sm, 1.0f, lane);
      bf16_t* q = (bf16_t*)(ws + WS_Q) + (size_t)t * DM + lane * 16; *(u32x4*)q = pk8(x); *(u32x4*)(q + 8) = pk8(x + 8); }
    { float x[16]; unpk8(T.k0, x); unpk8(T.k1, x + 8); norm_rope_regs<16, true>(x, kg, cm, sm, 1.0f, lane);
      if (lane < 16) { u32x4 o; o.x = fp8x4(x[0], x[1], x[2], x[3]); o.y = fp8x4(x[4], x[5], x[6], x[7]); o.z = fp8x4(x[8], x[9], x[10], x[11]); o.w = fp8x4(x[12], x[13], x[14], x[15]);
          *(u32x4*)(ws + WS_K8 + (size_t)t * 256 + lane * 16) = o;
          float y[16]; unpk8(T.v0, y); unpk8(T.v1, y + 8);
          o.x = fp8x4(y[0], y[1], y[2], y[3]); o.y = fp8x4(y[4], y[5], y[6], y[7]); o.z = fp8x4(y[8], y[9], y[10], y[11]); o.w = fp8x4(y[12], y[13], y[14], y[15]);
          *(u32x4*)(ws + WS_V8 + (size_t)t * 256 + lane * 16) = o; } }
    { float x[8]; unpk8(T.qi, x); norm_rope_regs<8, false>(x, ig, ci, si, 1.0f, lane); *(u32x4*)((bf16_t*)(ws + WS_QIDX) + (size_t)t * 512 + lane * 8) = pk8(x); }
    { float x[8]; unpk8(T.ki, x); norm_rope_regs<8, true>(x, ig, ci, si, 1.0f, lane); if (lane < 8) *(u32x4*)(ws + WS_KIDX + (size_t)(t >> 5) * 4096 + lane * 512 + (t & 31) * 16) = pk8(x); }
    if (lane < 8) ((float*)(ws + WS_WIDX))[(size_t)t * 8 + lane] = bf2f((unsigned short)T.wr) * 0.044194173824159216f;
}
__device__ __forceinline__ void p2_postproj(Frame& F, const Args& a) {
    const int gw = F.vcu * NWAVES + F.wave, NGW = F.G * NWAVES, lane = F.lane; unsigned char* ws = F.ws;
    if (gw >= NTOK) return;
    PPTok cur; pp_load(cur, ws, gw, lane);
    for (int t = gw; t < NTOK; t += NGW) {
        PPTok nxt; const int tn = t + NGW < NTOK ? t + NGW : t; pp_load(nxt, ws, tn, lane);
        pp_finish(cur, ws, a, t, lane);
        cur = nxt;
    }
}

constexpr int LRU_TC = 256, LRU_L = 64, LRU_NSC = SEQ / LRU_L, XA_STRIDE = 272, LRU_XA_BYTES = LRU_TC * XA_STRIDE, LRU_GT_OFF = 76800;
template <int PASS>
__device__ __forceinline__ void lru_unit(Frame& F, const Args& a, int b, int n, int j) {
    unsigned char* ws = F.ws; const int tid = F.tid, lane = F.lane, wave = F.wave;
    LAS unsigned char* xa = F.lds;
    LAS float* partA = (LAS float*)(F.lds + LRU_XA_BYTES); LAS float* partH = partA + 512; LAS float* carry = partH + 512;
    const int t0 = j * LRU_TC;
    float* lsA = (float*)(ws + WS_LSUM); float* lsH = lsA + (size_t)NB * LRU_NSC * DM;
    {
        const int cg = tid & 15, rg = tid >> 4; const int chb = 128 * n + 8 * cg;
        const bf16_t* X = (const bf16_t*)(ws + WS_LRUX) + (size_t)(b * SEQ) * DM + chb;
        const float* cw = (const float*)a.in[4]; const float* cbp = (const float*)a.in[5];
        float w[4][8], bias[8];
#pragma unroll
        for (int k = 0; k < 4; ++k) { const f32x4 u0 = *(const f32x4*)(cw + k * DM + chb), u1 = *(const f32x4*)(cw + k * DM + chb + 4);
            w[k][0] = u0.x; w[k][1] = u0.y; w[k][2] = u0.z; w[k][3] = u0.w; w[k][4] = u1.x; w[k][5] = u1.y; w[k][6] = u1.z; w[k][7] = u1.w; }
        { const f32x4 u0 = *(const f32x4*)(cbp + chb), u1 = *(const f32x4*)(cbp + chb + 4); bias[0] = u0.x; bias[1] = u0.y; bias[2] = u0.z; bias[3] = u0.w; bias[4] = u1.x; bias[5] = u1.y; bias[6] = u1.z; bias[7] = u1.w; }
        u32x4 xr[11];
#pragma unroll
        for (int i = 0; i < 11; ++i) { const int tt = t0 + 8 * rg - 3 + i; xr[i] = tt >= 0 ? *(const u32x4*)(X + (size_t)tt * DM) : (u32x4){0u, 0u, 0u, 0u}; }
#pragma unroll
        for (int r = 0; r < 8; ++r) { float o[8];
#pragma unroll
            for (int e = 0; e < 8; ++e) o[e] = bias[e];
#pragma unroll
            for (int k = 0; k < 4; ++k) { const u32x4 v = xr[r + k];
                o[0] += w[k][0] * bflo(v.x); o[1] += w[k][1] * bfhi(v.x); o[2] += w[k][2] * bflo(v.y); o[3] += w[k][3] * bfhi(v.y);
                o[4] += w[k][4] * bflo(v.z); o[5] += w[k][5] * bfhi(v.z); o[6] += w[k][6] * bflo(v.w); o[7] += w[k][7] * bfhi(v.w); }
            u32x4 pkd; pkd.x = pk2(o[0], o[1]); pkd.y = pk2(o[2], o[3]); pkd.z = pk2(o[4], o[5]); pkd.w = pk2(o[6], o[7]);
            *(LAS u32x4*)(xa + (8 * rg + r) * XA_STRIDE + cg * 16) = pkd; }
    }
    LAS unsigned char* gt = F.lds + LRU_GT_OFF;
    if (PASS == 1) {
        const int cg = tid & 15, rg = tid >> 4; const bf16_t* G = (const bf16_t*)(ws + WS_GATE) + (size_t)(b * SEQ + t0) * DM + 128 * n + 8 * cg;
        asm volatile("" ::: "memory");
#pragma unroll 2
        for (int r = 0; r < 8; ++r) *(LAS u32x4*)(gt + (8 * rg + r) * XA_STRIDE + cg * 16) = *(const u32x4*)(G + (size_t)(8 * rg + r) * DM);
        asm volatile("" ::: "memory");
    }
    if (PASS == 1) {
        const int chl = tid & 127, part = tid >> 7; const size_t cb = (size_t)b * LRU_NSC * DM + 128 * n + chl;
        float Ac = 1.f, Hc = 0.f;
        for (int s = part * j; s < (part + 1) * j; ++s) { const float As = lsA[cb + (size_t)s * DM], Hs = lsH[cb + (size_t)s * DM]; Hc = As * Hc + Hs; Ac = As * Ac; }
        partA[part * 128 + chl] = Ac; partH[part * 128 + chl] = Hc;
        __syncthreads();
        if (part == 0) { float h = 0.f;
#pragma unroll
            for (int p = 0; p < 4; ++p) h = partA[p * 128 + chl] * h + partH[p * 128 + chl];
            carry[chl] = h;
#pragma unroll
            for (int q = 0; q < 3; ++q) { const int s = 4 * j + q; h = lsA[cb + (size_t)s * DM] * h + lsH[cb + (size_t)s * DM]; carry[(q + 1) * 128 + chl] = h; } }
    }
    __syncthreads();
    {
        const int sb = wave & 3, th = wave >> 2, hh = lane >> 5, d = 32 * sb + (lane & 31), ch = 128 * n + d;
        const bf16_t* WG = (const bf16_t*)(ws + WS_WG);
        bf16x8 Wr[8], Wi[8];
#pragma unroll
        for (int s = 0; s < 8; ++s) { Wr[s] = *(const bf16x8*)(WG + ((size_t)(n * 2 + 0) * 128 + d) * 128 + 16 * s + 8 * hh); Wi[s] = *(const bf16x8*)(WG + ((size_t)(n * 2 + 1) * 128 + d) * 128 + 16 * s + 8 * hh); }
        const float br = ((const float*)a.in[7])[ch], bi = ((const float*)a.in[9])[ch];
        const float sp8 = -8.0f * log1pf(expf(-((const float*)a.in[10])[ch]));
        float h = PASS == 1 ? carry[(2 * th + hh) * 128 + d] : 0.f, P = 1.f;
        const int rA = lane & 31, tlA = (2 * th + ((rA >> 2) & 1)) * 64 + (rA & 3) + 4 * (rA >> 3);
#pragma unroll 1
        for (int i = 0; i < 4; ++i) {
            f32x16 ar, ai;
#pragma unroll
            for (int e = 0; e < 16; ++e) { ar[e] = 0.f; ai[e] = 0.f; }
#pragma unroll
            for (int s = 0; s < 8; ++s) { const bf16x8 af = *(const LAS bf16x8*)(xa + (tlA + 16 * i) * XA_STRIDE + (16 * s + 8 * hh) * 2);
                ar = __builtin_amdgcn_mfma_f32_32x32x16_bf16(af, Wr[s], ar, 0, 0, 0); ai = __builtin_amdgcn_mfma_f32_32x32x16_bf16(af, Wi[s], ai, 0, 0, 0); }
            const int tl0 = (2 * th + hh) * 64 + 16 * i;
#pragma unroll
            for (int e = 0; e < 16; ++e) {
                const int tl = tl0 + e;
                const float xav = bf2f(*(const LAS bf16_t*)(xa + tl * XA_STRIDE + d * 2));
                const float r = sigmoidf_(ar[e] + br), ig = sigmoidf_(ai[e] + bi);
                const float la = sp8 * r, av = fast_exp(la), m2 = __builtin_fmaf(-av, av, 1.0f);
                const float u = __builtin_amdgcn_sqrtf(m2) * ig * xav;
                h = av * h + u;
                if (PASS == 0) P *= av;
                else { LAS bf16_t* gp = (LAS bf16_t*)(gt + tl * XA_STRIDE + d * 2); *gp = (bf16_t)f2bf(h * bf2f(*gp)); }
            }
        }
        if (PASS == 0) { const size_t o = ((size_t)b * LRU_NSC + 4 * j + 2 * th + hh) * DM + ch; lsA[o] = P; lsH[o] = h; }
    }
    __syncthreads();
    if (PASS == 1) {
        const int cg = tid & 15, rg = tid >> 4; bf16_t* Y = (bf16_t*)(ws + WS_XN) + (size_t)(b * SEQ + t0) * DM + 128 * n + 8 * cg;
#pragma unroll 2
        for (int r = 0; r < 8; ++r) *(u32x4*)(Y + (size_t)(8 * rg + r) * DM) = *(const LAS u32x4*)(gt + (8 * rg + r) * XA_STRIDE + cg * 16);
        __syncthreads();
    }
}
template <int PASS> __device__ __forceinline__ void lru_phase(Frame& F, const Args& a) {
    for (int u4 = F.vcu; u4 < 256; u4 += F.G)
        for (int i = 0; i < 4; ++i) { const int uid = u4 * 4 + i; lru_unit<PASS>(F, a, uid >> 8, uid & 7, (uid >> 3) & 31); }
}

__device__ __forceinline__ void p7_router(Frame& F, const Args& a) {
    const int lane = F.lane; unsigned char* ws = F.ws;
    const bf16_t* xm = (const bf16_t*)(ws + WS_XMID); const float* wrt = (const float*)(ws + WS_WR); float* rstdE = (float*)(ws + WS_RSTDE);
    int* tokE = (int*)(ws + WS_TOKE); float* gateE = (float*)(ws + WS_GATEE); int* tinfo = (int*)(ws + WS_TINFO);
    unsigned* ecnt = F.ctl + CW_ECNT;
    LAS float* lg = (LAS float*)(F.lds + F.wave * 4096);
    const int ri = lane & 15, kk = lane >> 4;
    LAS unsigned* lc = (LAS unsigned*)(F.lds + NWAVES * 4096); LAS unsigned* gb = lc + 32;
    for (int mb = F.vcu * (NWAVES * 16); mb < NTOK; mb += F.G * (NWAVES * 16)) {
        const int m0 = mb + F.wave * 16;
        if (F.tid < 32) lc[F.tid] = 0u;
        const u32x4* ap = (const u32x4*)(xm + (size_t)(m0 + ri) * DM) + kk;
        const f32x4* bp0 = (const f32x4*)(wrt + (size_t)(ri) * DM) + 2 * kk;
        const f32x4* bp1 = (const f32x4*)(wrt + (size_t)(16 + ri) * DM) + 2 * kk;
        const f32x4* bp2 = (const f32x4*)(wrt + (size_t)(ri < 4 ? 32 + ri : 35) * DM) + 2 * kk;
        f32x4 acc0 = (f32x4){0.f, 0.f, 0.f, 0.f}, acc1 = acc0, acc2 = acc0; float ssq = 0.f;
#pragma unroll 2
        for (int s = 0; s < 32; ++s) { const u32x4 aw = ap[4 * s];
            const f32x4 b00 = bp0[8 * s], b01 = bp0[8 * s + 1], b10 = bp1[8 * s], b11 = bp1[8 * s + 1], b20 = bp2[8 * s], b21 = bp2[8 * s + 1];
            const f32x4 a0 = (f32x4){bflo(aw.x), bfhi(aw.x), bflo(aw.y), bfhi(aw.y)}, a1 = (f32x4){bflo(aw.z), bfhi(aw.z), bflo(aw.w), bfhi(aw.w)};
            ssq += ((a0.x * a0.x + a0.y * a0.y) + (a0.z * a0.z + a0.w * a0.w)) + ((a1.x * a1.x + a1.y * a1.y) + (a1.z * a1.z + a1.w * a1.w));
#pragma unroll
            for (int e = 0; e < 4; ++e) { acc0 = __builtin_amdgcn_mfma_f32_16x16x4f32(a0[e], b00[e], acc0, 0, 0, 0); acc1 = __builtin_amdgcn_mfma_f32_16x16x4f32(a0[e], b10[e], acc1, 0, 0, 0); acc2 = __builtin_amdgcn_mfma_f32_16x16x4f32(a0[e], b20[e], acc2, 0, 0, 0); }
#pragma unroll
            for (int e = 0; e < 4; ++e) { acc0 = __builtin_amdgcn_mfma_f32_16x16x4f32(a1[e], b01[e], acc0, 0, 0, 0); acc1 = __builtin_amdgcn_mfma_f32_16x16x4f32(a1[e], b11[e], acc1, 0, 0, 0); acc2 = __builtin_amdgcn_mfma_f32_16x16x4f32(a1[e], b21[e], acc2, 0, 0, 0); } }
        ssq += __shfl_xor(ssq, 16); ssq += __shfl_xor(ssq, 32);
        const float rstd = 1.0f / sqrtf(ssq * (1.f / DM) + NORM_EPS);
#pragma unroll
        for (int e = 0; e < 4; ++e) { lg[(4 * kk + e) * 48 + ri] = acc0[e]; lg[(4 * kk + e) * 48 + 16 + ri] = acc1[e]; lg[(4 * kk + e) * 48 + 32 + ri] = acc2[e]; }
        if (kk == 0) lg[768 + ri] = rstd;
        asm volatile("s_waitcnt lgkmcnt(0)" ::: "memory");
        int e1 = 0, e2 = 0; float g1 = 0.f, g2 = 0.f, rs = 0.f;
        if (lane < 16) {
            rs = lg[768 + lane]; const float* bg = (const float*)a.in[19]; const float* be = (const float*)a.in[21];
            float gl[4]; int gs = 0; float gmax = -__builtin_inff();
#pragma unroll
            for (int c = 0; c < 4; ++c) { gl[c] = lg[lane * 48 + c] * rs + bg[c]; if (gl[c] > gmax) { gmax = gl[c]; gs = c; } }
            float gsum = 0.f;
#pragma unroll
            for (int c = 0; c < 4; ++c) gsum += fast_exp(gl[c] - gmax);
            const float pgrp = 1.0f / gsum;
            float m1 = -__builtin_inff(), mx2 = -__builtin_inff(); int j1 = 0, j2 = 0;
            for (int c = 0; c < 8; ++c) { const float v = lg[lane * 48 + 4 + 8 * gs + c] * rs + be[8 * gs + c];
                if (v > m1) { mx2 = m1; j2 = j1; m1 = v; j1 = c; } else if (v > mx2) { mx2 = v; j2 = c; } }
            const float ex = fast_exp(mx2 - m1); g1 = pgrp / (1.0f + ex); g2 = pgrp - g1;
            e1 = 8 * gs + j1; e2 = 8 * gs + j2;
        }
        __syncthreads();
        unsigned l1 = 0u, l2 = 0u;
        if (lane < 16) { l1 = __hip_atomic_fetch_add(lc + e1, 1u, __ATOMIC_RELAXED, __HIP_MEMORY_SCOPE_WORKGROUP); l2 = __hip_atomic_fetch_add(lc + e2, 1u, __ATOMIC_RELAXED, __HIP_MEMORY_SCOPE_WORKGROUP); }
        __syncthreads();
        if (F.tid < 32) { const unsigned n = lc[F.tid]; gb[F.tid] = n ? __hip_atomic_fetch_add(ecnt + 64 * F.tid, n, RLX_AGENT) : 0u; }
        __syncthreads();
        if (lane < 16) { const int tok = m0 + lane, p1 = (int)(gb[e1] + l1), p2 = (int)(gb[e2] + l2);
            tokE[(size_t)e1 * NTOK + p1] = tok; gateE[(size_t)e1 * NTOK + p1] = g1; tokE[(size_t)e2 * NTOK + p2] = tok; gateE[(size_t)e2 * NTOK + p2] = g2;
            rstdE[(size_t)e1 * NTOK + p1] = rs; rstdE[(size_t)e2 * NTOK + p2] = rs;
            *(int4*)(tinfo + (size_t)tok * 4) = make_int4(e1, p1, e2, p2);
        }
        asm volatile("s_waitcnt lgkmcnt(0)" ::: "memory");
    }
}

constexpr int MOE_LDS_OFF = LDSCTL_OFF + 1024;
__device__ __forceinline__ void moe_sched_setup(Frame& F) {
    LAS int* sc = (LAS int*)(F.lds + MOE_LDS_OFF);
    if (F.tid < 32) sc[F.tid] = (int)__hip_atomic_load(F.ctl + CW_ECNT + 64 * F.tid, RLX_AGENT);
    __syncthreads();
    if (F.tid == 0) { int s = 0; for (int e = 0; e < 32; ++e) { sc[32 + e] = s; s += (sc[e] + 255) >> 8; } sc[64] = s; }
    __syncthreads();
}
template <bool GATHER> struct GroupOrder {
    LAS const int* sc; int G, c; const char* W; size_t estride, tstepB; const int* tokE;
    __device__ __forceinline__ bool next(int i, Unit& u) const {
        const int L = i * G + c, TM = sc[64]; if (L >= 4 * TM) return false;
        const int rt = L >> 2, pn = L & 3; int e = 0;
        for (int q = 1; q < 32; ++q) e = sc[32 + q] <= rt ? q : e;
        u.pm = rt; u.pn = pn; u.aux = e * 128 + (rt - sc[32 + e]); u.B = W + (size_t)e * estride + (size_t)pn * tstepB; return true;
    }
    __device__ __forceinline__ int arow(const Unit& u, int r) const {
        if (!GATHER) return u.pm * 256 + r;
        const int e = u.aux >> 7, idx = (u.aux & 127) * 256 + r;
        return idx < sc[e] ? tokE[(size_t)e * NTOK + idx] : 0;
    }
};
__device__ __forceinline__ void p10_combine(Frame& F, const Args& a) {
    const int gw = F.vcu * NWAVES + F.wave, NGW = F.G * NWAVES, lane = F.lane; unsigned char* ws = F.ws;
    LAS const int* sc = (LAS const int*)(F.lds + MOE_LDS_OFF);
    const int* tinfo = (const int*)(ws + WS_TINFO); const bf16_t* y = (const bf16_t*)(ws + WS_Y); float* out = a.out;
    for (int t = gw; t < NTOK; t += NGW) {
        const int4 ti = *(const int4*)(tinfo + (size_t)t * 4);
        const size_t s1 = (size_t)sc[32 + ti.x] * 256 + ti.y, s2 = (size_t)sc[32 + ti.z] * 256 + ti.w;
        GAS f32x4* xr = (GAS f32x4*)(out + (size_t)t * DM) + lane; const GAS u32x2* xm = (const GAS u32x2*)((const bf16_t*)(ws + WS_XMID) + (size_t)t * DM) + lane;
        const GAS u32x2* y1 = (const GAS u32x2*)(y + s1 * DM) + lane; const GAS u32x2* y2 = (const GAS u32x2*)(y + s2 * DM) + lane;
#pragma unroll
        for (int j = 0; j < 4; ++j) { const u32x2 xw = xm[64 * j]; f32x4 v = (f32x4){bflo(xw.x), bfhi(xw.x), bflo(xw.y), bfhi(xw.y)}; const u32x2 p = y1[64 * j], q = y2[64 * j];
            v.x += bflo(p.x) + bflo(q.x); v.y += bfhi(p.x) + bfhi(q.x); v.z += bflo(p.y) + bflo(q.y); v.w += bfhi(p.y) + bfhi(q.y);
            xr[64 * j] = v; }
    }
}


constexpr int CAP = 576, S1_KS = 64;
__device__ __forceinline__ unsigned mbcnt64(unsigned long long m) { return __builtin_amdgcn_mbcnt_hi((unsigned)(m >> 32), __builtin_amdgcn_mbcnt_lo((unsigned)m, 0u)); }
__device__ __forceinline__ unsigned wave_or_u32(unsigned v) {
    v |= (unsigned)__builtin_amdgcn_update_dpp(0, (int)v, 0x121, 0xF, 0xF, false); v |= (unsigned)__builtin_amdgcn_update_dpp(0, (int)v, 0x122, 0xF, 0xF, false);
    v |= (unsigned)__builtin_amdgcn_update_dpp(0, (int)v, 0x124, 0xF, 0xF, false); v |= (unsigned)__builtin_amdgcn_update_dpp(0, (int)v, 0x128, 0xF, 0xF, false);
    return (unsigned)__builtin_amdgcn_readlane((int)v, 0) | (unsigned)__builtin_amdgcn_readlane((int)v, 16) | (unsigned)__builtin_amdgcn_readlane((int)v, 32) | (unsigned)__builtin_amdgcn_readlane((int)v, 48);
}
template <bool REWRITE>
__device__ __forceinline__ unsigned select_rank(LAS unsigned* qb, int n, int lane, int& newcnt, const int target, const int slack) {
    unsigned e[9]; unsigned orl = 0u, norl = 0u;
#pragma unroll
    for (int i = 0; i < 9; ++i) { const int idx = lane + 64 * i; const bool ok = idx < n; e[i] = ok ? qb[idx] : 0u; orl |= e[i]; norl |= ok ? ~e[i] : 0u; }
    const unsigned orv = wave_or_u32(orl), andv = ~wave_or_u32(norl), diff = orv ^ andv;
    const int hb = 31 - __builtin_clz(diff | 1u);
    unsigned T = andv & ~((2u << hb) - 1u); int cT = n;
    for (int bit = hb; bit >= 0; --bit) {
        const unsigned cand = T | (1u << bit); int c = 0;
#pragma unroll
        for (int i = 0; i < 9; ++i) c += __builtin_popcountll(__ballot(e[i] >= cand));
        if (c >= target) { T = cand; cT = c; if (c <= target + slack) break; }
    }
    if (REWRITE) { int base = 0;
#pragma unroll
        for (int i = 0; i < 9; ++i) { const bool keep = e[i] >= T; const unsigned long long m = __ballot(keep); if (keep) qb[base + (int)mbcnt64(m)] = e[i]; base += __builtin_popcountll(m); }
        newcnt = base; }
    else newcnt = cT;
    return T;
}
template <bool FINAL>
__device__ __forceinline__ unsigned select256(LAS unsigned* qb, int n, int lane, int& newcnt) { return select_rank<true>(qb, n, lane, newcnt, 256, FINAL ? 0 : 64); }
__device__ __forceinline__ void dsa_chunk(Frame& F, const Args& a, int b, int c) {
    unsigned char* ws = F.ws; const int lane = F.lane, wave = F.wave, hh = lane >> 5;
    LAS unsigned* wbuf = (LAS unsigned*)(F.lds + wave * (8 * CAP * 4));
    const int qbase = b * SEQ + c * 64 + 8 * wave;
    int nsel[8];
    {
        const bf16_t* QI = (const bf16_t*)(ws + WS_QIDX); const float* WI = (const float*)(ws + WS_WIDX); const bf16_t* KI = (const bf16_t*)(ws + WS_KIDX) + (size_t)b * SEQ * 64;
        bf16x8 Aq[2][4]; float wv[2][16];
        { const int r = lane & 31, j_ = r & 3, hb = (r >> 2) & 1, g = r >> 3, h = j_ + 4 * (g & 1), tq = hb + 2 * (g >> 1);
#pragma unroll
          for (int rt = 0; rt < 2; ++rt)
#pragma unroll
              for (int s = 0; s < 4; ++s) Aq[rt][s] = *(const bf16x8*)(QI + (size_t)(qbase + 4 * rt + tq) * 512 + h * 64 + 16 * s + 8 * hh);
#pragma unroll
          for (int rt = 0; rt < 2; ++rt)
#pragma unroll
              for (int gq = 0; gq < 2; ++gq) { const float* wp = WI + (size_t)(qbase + 4 * rt + hh + 2 * gq) * 8; const f32x4 w0 = *(const f32x4*)wp, w1 = *(const f32x4*)(wp + 4);
                  wv[rt][8 * gq + 0] = w0.x; wv[rt][8 * gq + 1] = w0.y; wv[rt][8 * gq + 2] = w0.z; wv[rt][8 * gq + 3] = w0.w; wv[rt][8 * gq + 4] = w1.x; wv[rt][8 * gq + 5] = w1.y; wv[rt][8 * gq + 6] = w1.z; wv[rt][8 * gq + 7] = w1.w; } }
        unsigned thr[4] = {0u, 0u, 0u, 0u}; int cntv[4] = {0, 0, 0, 0};
        const int nkt = (c + 1) * 2;
        const char* KIb = (const char*)KI;
        auto scan = [&](const int st, const int njt, const int keep) {
            bf16x8 Bq[2][4];
#pragma unroll
            for (int i = 0; i < 2; ++i) { const int kti = (i < njt ? i : njt - 1) * st;
#pragma unroll
                for (int s = 0; s < 4; ++s) Bq[i][s] = *(const bf16x8*)(KIb + (size_t)kti * 4096 + (2 * s + hh) * 512 + (lane & 31) * 16); }
            int j = 0;
#pragma unroll 1
            while (j < njt) {
                int mxc = 0;
#pragma unroll
                for (int k = 0; k < 4; ++k) { const int n0 = __builtin_amdgcn_readlane(cntv[k], 0), n1 = __builtin_amdgcn_readlane(cntv[k], 32); mxc = n0 > mxc ? n0 : mxc; mxc = n1 > mxc ? n1 : mxc; }
                const int run = ((CAP - mxc) >> 5) & ~1;
                if (run == 0) {
#pragma unroll
                    for (int k = 0; k < 4; ++k)
#pragma unroll
                        for (int hq = 0; hq < 2; ++hq) { const int n = __builtin_amdgcn_readlane(cntv[k], 32 * hq);
                            if (n > CAP - 64) { int nc; const unsigned T = select_rank<true>(wbuf + (2 * k + hq) * CAP, n, lane, nc, keep, 64);
                                if (hh == hq) { thr[k] = T - 1u; cntv[k] = nc; } } }
                    continue;
                }
                const int jend = j + run < njt ? j + run : njt;
#pragma unroll 1
                for (; j < jend; j += 2) {
#pragma unroll
                    for (int i = 0; i < 2; ++i) {
                        const int jj = j + i;
                        if (jj < jend) {
                            const int kti = jj * st;
                            const unsigned kinv = 8191u - (unsigned)(32 * kti + (lane & 31));
                            f32x16 accs[2];
#pragma unroll
                            for (int rt = 0; rt < 2; ++rt) {
#pragma unroll
                                for (int e = 0; e < 16; ++e) accs[rt][e] = 0.f;
#pragma unroll
                                for (int s = 0; s < 4; ++s) accs[rt] = __builtin_amdgcn_mfma_f32_32x32x16_bf16(Aq[rt][s], Bq[i][s], accs[rt], 0, 0, 0); }
                            asm volatile("s_nop 15" : "+v"(accs[0]), "+v"(accs[1]));
                            { const int ktn = (jj + 2 < njt ? jj + 2 : njt - 1) * st;
#pragma unroll
                              for (int s = 0; s < 4; ++s) Bq[i][s] = *(const bf16x8*)(KIb + (size_t)ktn * 4096 + (2 * s + hh) * 512 + (lane & 31) * 16); }
                            unsigned keys[4];
#pragma unroll
                            for (int rt = 0; rt < 2; ++rt) {
                                const f32x16 acc = accs[rt];
#pragma unroll
                                for (int gq = 0; gq < 2; ++gq) {
                                    float s0 = 0.f, s1 = 0.f;
#pragma unroll
                                    for (int h = 0; h < 8; h += 2) { float m0, m1; asm("v_max_f32_e32 %0, 0, %1" : "=v"(m0) : "v"(acc[8 * gq + h])); asm("v_max_f32_e32 %0, 0, %1" : "=v"(m1) : "v"(acc[8 * gq + h + 1]));
                                        s0 = __builtin_fmaf(wv[rt][8 * gq + h], m0, s0); s1 = __builtin_fmaf(wv[rt][8 * gq + h + 1], m1, s1); }
                                    const float sc = s0 + s1;
                                    const unsigned u = __builtin_bit_cast(unsigned, sc); const unsigned ord = u ^ ((unsigned)((int)u >> 31) | 0x80000000u);
                                    keys[2 * rt + gq] = (ord & 0xFFFFE000u) | kinv;
                                }
                            }
#pragma unroll
                            for (int k = 0; k < 4; ++k) {
                                const unsigned key = keys[k];
                                const bool pass = key > thr[k];
                                const unsigned long long m = __ballot(pass);
                                if (m) { const unsigned mlo = (unsigned)m, mhi = (unsigned)(m >> 32);
                                    const unsigned pre = __builtin_amdgcn_mbcnt_hi(hh ? mhi : 0u, __builtin_amdgcn_mbcnt_lo(hh ? 0u : mlo, 0u));
                                    if (pass) wbuf[(2 * k + hh) * CAP + cntv[k] + (int)pre] = key;
                                    cntv[k] += hh ? __builtin_popcount(mhi) : __builtin_popcount(mlo); }
                            }
                        }
                    }
                }
                j = jend;
            }
        };
        bool sampled = false;
        if (nkt >= 64) {
            sampled = true;
            scan(8, nkt >> 3, S1_KS);
#pragma unroll
            for (int k = 0; k < 4; ++k)
#pragma unroll
                for (int hq = 0; hq < 2; ++hq) { const int n = __builtin_amdgcn_readlane(cntv[k], 32 * hq); unsigned T = 1u;
                    if (n > S1_KS) { int nc; T = select_rank<false>(wbuf + (2 * k + hq) * CAP, n, lane, nc, S1_KS, 8); }
                    if (hh == hq) { thr[k] = T - 1u; cntv[k] = 0; } }
        }
        for (;;) {
            scan(1, nkt, 256);
            bool shortfall = false;
#pragma unroll
            for (int k = 0; k < 4; ++k)
#pragma unroll
                for (int hq = 0; hq < 2; ++hq) { int n = __builtin_amdgcn_readlane(cntv[k], 32 * hq);
                    if (n > 256) { int nc; (void)select256<true>(wbuf + (2 * k + hq) * CAP, n, lane, nc); n = nc; }
                    else if (n < 256 && sampled) shortfall = true;
                    nsel[2 * k + hq] = n; }
            if (!shortfall) break;
            sampled = false;
#pragma unroll
            for (int k = 0; k < 4; ++k) { thr[k] = 0u; cntv[k] = 0; }
        }
    }
    unsigned short* LIST = (unsigned short*)(ws + WS_LIST);
#pragma unroll
    for (int qi = 0; qi < 8; ++qi) { const int ns = nsel[qi]; const u32x4 kq = *(const LAS u32x4*)(wbuf + qi * CAP + 4 * lane);
        const unsigned i0 = 4 * lane + 0 < ns ? 8191u - (kq.x & 0x1FFFu) : 0u, i1 = 4 * lane + 1 < ns ? 8191u - (kq.y & 0x1FFFu) : 0u, i2 = 4 * lane + 2 < ns ? 8191u - (kq.z & 0x1FFFu) : 0u, i3 = 4 * lane + 3 < ns ? 8191u - (kq.w & 0x1FFFu) : 0u;
        u32x2 o; o.x = i0 | (i1 << 16); o.y = i2 | (i3 << 16);
        *(u32x2*)(LIST + (size_t)(qbase + qi) * 256 + 4 * lane) = o; }
}
__device__ __forceinline__ void dsa_phase(Frame& F, const Args& a) {
    for (int p = F.vcu; p < 256; p += F.G) { const int b = p >> 6, c0 = p & 63; dsa_chunk(F, a, b, c0); dsa_chunk(F, a, b, 127 - c0); }
}


typedef short v4i16_t __attribute__((ext_vector_type(4)));
constexpr int S2_WAVE_LDS = 17408, S2_LIST_OFF = 16384;
#define S2_WAIT(n) asm volatile("s_waitcnt vmcnt(" #n ")" ::: "memory")
__device__ __forceinline__ void dsa2_item(Frame& F, int b, int t, int j) {
    unsigned char* ws = F.ws; const int lane = F.lane, hd = lane & 15, g4 = lane >> 4;
    LAS unsigned char* wl = F.lds + F.wave * S2_WAVE_LDS;
    LAS unsigned short* lst = (LAS unsigned short*)(wl + S2_LIST_OFF);
    const size_t tq = (size_t)b * SEQ + t;
    const int nadm = ((t >> 6) + 1) * 64, ns = nadm < 256 ? nadm : 256;
    const bf16_t* Q = (const bf16_t*)(ws + WS_Q);
    const char* Kb = (const char*)(ws + WS_K8) + (size_t)b * SEQ * 256 + j * 128; const char* Vb = (const char*)(ws + WS_V8) + (size_t)b * SEQ * 256 + j * 128;
    { const u32x2 lv = *(const u32x2*)((const unsigned short*)(ws + WS_LIST) + tq * 256 + 4 * lane);
      bf16x8 qf[4];
#pragma unroll
      for (int s = 0; s < 4; ++s) qf[s] = *(const bf16x8*)(Q + tq * DM + (4 * j + (hd & 3)) * 128 + 32 * s + 8 * g4);
      S2_WAIT(0);
      *(LAS u32x2*)(lst + 4 * lane) = lv;
      asm volatile("s_waitcnt lgkmcnt(0)" ::: "memory");
      long Bq[4];
#pragma unroll
      for (int s = 0; s < 4; ++s) { const u32x4 qv = __builtin_bit_cast(u32x4, qf[s]);
          const unsigned lo = fp8x4(bflo(qv.x), bfhi(qv.x), bflo(qv.y), bfhi(qv.y)), hi = fp8x4(bflo(qv.z), bfhi(qv.z), bflo(qv.w), bfhi(qv.w));
          Bq[s] = hd < 4 ? (long)(((unsigned long long)hi << 32) | lo) : 0l; }
      const int dr8 = lane >> 3, dc8 = lane & 7;
#define S2_DMAK(g_) do { _Pragma("unroll") for (int _m = 0; _m < 2; ++_m) { const int _row = 8 * _m + dr8; const unsigned _kx = lst[16 * (g_) + _row]; \
          __builtin_amdgcn_global_load_lds((const unsigned*)(Kb + (size_t)_kx * 256 + ((dc8 ^ (_row & 7)) << 4)), (LAS unsigned*)(wl + ((g_) & 7) * 2048 + _m * 1024), 16, 0, 0); } } while (0)
      S2_DMAK(0); S2_DMAK(1); S2_DMAK(2); S2_DMAK(3); S2_DMAK(4); S2_DMAK(5);
      f32x4 sreg[16];
#pragma unroll
      for (int g = 0; g < 16; ++g) {
          if (g + 6 < 16) { S2_DMAK(g + 6); S2_WAIT(12); } else if (g == 10) { S2_WAIT(10); } else if (g == 11) { S2_WAIT(8); } else if (g == 12) { S2_WAIT(6); } else if (g == 13) { S2_WAIT(4); } else if (g == 14) { S2_WAIT(2); } else { S2_WAIT(0); }
          LAS const unsigned char* sl = wl + (g & 7) * 2048 + hd * 128 + (g4 & 1) * 8;
          f32x4 acc = (f32x4){0.f, 0.f, 0.f, 0.f};
#pragma unroll
          for (int s = 0; s < 4; ++s) { const long af = *(const LAS long*)(sl + (((2 * s + (g4 >> 1)) ^ (hd & 7)) << 4)); acc = __builtin_amdgcn_mfma_f32_16x16x32_fp8_fp8(af, Bq[s], acc, 0, 0, 0); }
          sreg[g] = acc;
      }
      if (ns < 256) {
#pragma unroll
          for (int g = 0; g < 16; ++g) if (!(16 * g < ns)) sreg[g] = (f32x4){-1e30f, -1e30f, -1e30f, -1e30f}; }
      asm volatile("s_waitcnt lgkmcnt(0)" ::: "memory");
#define S2_DMAV(g_) do { _Pragma("unroll") for (int _m = 0; _m < 2; ++_m) { const int _row = 8 * _m + dr8; const unsigned _kx = lst[16 * (g_) + _row]; \
          __builtin_amdgcn_global_load_lds((const unsigned*)(Vb + (size_t)_kx * 256 + ((dc8 ^ (_row & 7)) << 4)), (LAS unsigned*)(wl + ((g_) & 7) * 2048 + _m * 1024), 16, 0, 0); } } while (0)
      S2_DMAV(0); S2_DMAV(1); S2_DMAV(2); S2_DMAV(3); S2_DMAV(4); S2_DMAV(5);
      float mx = -1e30f;
#pragma unroll
      for (int g = 0; g < 16; ++g) mx = fmaxf(mx, fmaxf(fmaxf(sreg[g][0], sreg[g][1]), fmaxf(sreg[g][2], sreg[g][3])));
      mx = fmaxf(mx, __shfl_xor(mx, 16)); mx = fmaxf(mx, __shfl_xor(mx, 32));
      const float mxb = 8.0f - mx * QSCALE;
      float lsp[4] = {0.f, 0.f, 0.f, 0.f};
#pragma unroll
      for (int g = 0; g < 16; ++g)
#pragma unroll
          for (int e = 0; e < 4; ++e) { const float p = __builtin_amdgcn_exp2f(__builtin_fmaf(sreg[g][e], QSCALE, mxb)); sreg[g][e] = p; lsp[e] += p; }
      float ls = (lsp[0] + lsp[1]) + (lsp[2] + lsp[3]);
      ls += __shfl_xor(ls, 16); ls += __shfl_xor(ls, 32);
      f32x4 o[8];
#pragma unroll
      for (int ct = 0; ct < 8; ++ct) o[ct] = (f32x4){0.f, 0.f, 0.f, 0.f};
      const int tq_ = hd >> 1, tp = hd & 1, trow = 4 * g4 + (tq_ & 3), tsel = tq_ >> 2;
      typedef int v2i32_t __attribute__((ext_vector_type(2)));
#pragma unroll
      for (int ks = 0; ks < 8; ++ks) {
          if (ks + 3 < 8) { S2_DMAV(2 * ks + 6); S2_DMAV(2 * ks + 7); }
          if (ks <= 4) { S2_WAIT(12); } else if (ks == 5) { S2_WAIT(8); } else if (ks == 6) { S2_WAIT(4); } else { S2_WAIT(0); }
          const unsigned plo = fp8x4(sreg[2 * ks][0], sreg[2 * ks][1], sreg[2 * ks][2], sreg[2 * ks][3]), phi = fp8x4(sreg[2 * ks + 1][0], sreg[2 * ks + 1][1], sreg[2 * ks + 1][2], sreg[2 * ks + 1][3]);
          const long af = (long)(((unsigned long long)phi << 32) | plo);
          LAS const unsigned char* sV = wl + (tsel ? ((2 * ks + 1) & 7) : ((2 * ks) & 7)) * 2048 + trow * 128 + tp * 8;
#pragma unroll
          for (int ct = 0; ct < 8; ++ct) { const v2i32_t bv = __builtin_amdgcn_ds_read_tr8_b64_v2i32((LAS v2i32_t*)(sV + ((ct ^ (trow & 7)) << 4)));
              o[ct] = __builtin_amdgcn_mfma_f32_16x16x32_fp8_fp8(af, __builtin_bit_cast(long, bv), o[ct], 0, 0, 0); }
          asm volatile("s_waitcnt lgkmcnt(0)" ::: "memory");
      }
#undef S2_DMAV
#undef S2_DMAK
      float li[4];
#pragma unroll
      for (int e = 0; e < 4; ++e) li[e] = 1.0f / __shfl(ls, e);
      if (g4 == 0) { bf16_t* yb = (bf16_t*)(ws + WS_Q) + tq * DM + (4 * j) * 128 + hd;
#pragma unroll
          for (int e = 0; e < 4; ++e)
#pragma unroll
              for (int ct = 0; ct < 8; ++ct) yb[e * 128 + 16 * ct] = (bf16_t)f2bf(o[ct][e] * li[e]); }
    }
}
__device__ __forceinline__ void dsa2_phase(Frame& F, const Args& a) {
    for (int p = F.vcu; p < 256; p += F.G) { const int x = p >> 5, b = x >> 1, j = x & 1, wl_ = (p & 31) * NWAVES + F.wave;
        for (int i = 0; i < 32; ++i) dsa2_item(F, b, wl_ + 256 * i, j); }
}

__global__ void __launch_bounds__(NWAVES * 64, 2) fwd_kernel(Args args) {
    extern __shared__ __attribute__((aligned(16))) unsigned char lds[];
    Frame F;
    F.lds = (LAS unsigned char*)lds; F.MISC = (volatile LAS unsigned*)(F.lds + MISC_OFF);
    F.tid = threadIdx.x; F.lane = F.tid & 63; F.wave = __builtin_amdgcn_readfirstlane(F.tid >> 6);
    F.G = gridDim.x; { const int bx = blockIdx.x; F.vcu = (F.G % 8 == 0) ? (bx % 8) * (F.G / 8) + bx / 8 : bx; }
    F.ws = args.ws; F.ctl = (unsigned*)(args.ws + WS_CTL);
    for (int u = F.tid; u < (LDS_BYTES - LDSCTL_OFF) / 4; u += NWAVES * 64) ((LAS unsigned*)(F.lds + LDSCTL_OFF))[u] = 0u;
    __syncthreads();
    XcdBarrier bar; bar.bar = F.ctl + CW_BAR; bar.x = 0; bar.st = nullptr;
    if (MK_N_LAUNCHES == 1) bar = xcd_barrier_post(F.ctl + CW_BAR, F.MISC + 8);
#define GRID_BAR() do { if (MK_N_LAUNCHES == 1) xcd_barrier(bar); } while (0)
    const int lo = args.ph_lo, hi = args.ph_hi;
#define IN(k) (lo <= (k) && (k) < hi)
#define BOTH(k) (IN(k) && IN((k) + 1))
    unsigned char* ws = args.ws;
    if (IN(0)) { p0_prologue(F, args); if (BOTH(0)) GRID_BAR(); }
    if (IN(1)) {
        pg8::Gemm g{(const char*)(ws + WS_XN), DM * 2, DM}; pg8::DenseOrder S; S.init(NTOK, NP, DM, F.G, (int)blockIdx.x, ws + WS_WIN);
        EpiProj E{ws, (unsigned char*)args.out};
        pg8::gemm_phase(F.lds, g, S, E);
        { LAS float* scr = (LAS float*)(F.lds + F.wave * 16384); const int lane = F.lane;
          tail_items(F, (int)blockIdx.x, S.nwg % F.G, I_W13 - DEF_W13, I_W13, [&](int r) { p0_item_w13(args, ws, r, scr, lane); }); }
        if (BOTH(1)) GRID_BAR();
    }
    if (IN(2)) { p2_postproj(F, args); __syncthreads(); lru_phase<0>(F, args); if (BOTH(2)) GRID_BAR(); }
    if (IN(3)) { lru_phase<1>(F, args);
        __syncthreads(); dsa_phase(F, args);
        if (BOTH(3)) GRID_BAR(); }
    auto g2a = [&]() {
        pg8::Gemm g{(const char*)(ws + WS_XN), DM * 2, DM}; pg8::DenseOrder S; S.init(NTOK, DM, DM, F.G, (int)blockIdx.x, ws + WS_WA);
        EpiMerge<false> E{(const bf16_t*)args.out, 0, nullptr, (bf16_t*)(ws + WS_LRUX)};
        pg8::gemm_phase(F.lds, g, S, E); };
    if (BOTH(4) && ((blockIdx.x >> 3) & 1)) { g2a(); __syncthreads(); dsa2_phase(F, args); __syncthreads(); if (BOTH(5)) GRID_BAR(); }
    else {
        if (IN(4)) { dsa2_phase(F, args); __syncthreads(); }
        if (IN(5)) { g2a(); if (BOTH(5)) GRID_BAR(); }
    }
    if (IN(6)) {
        pg8::Gemm g{(const char*)(ws + WS_Q), DM * 2, DM}; pg8::DenseOrder S; S.init(NTOK, DM, DM, F.G, (int)blockIdx.x, ws + WS_WB);
        EpiMerge<true> E{(const bf16_t*)args.out, 1024, (const bf16_t*)(ws + WS_LRUX), (bf16_t*)(ws + WS_GATE)};
        pg8::gemm_phase(F.lds, g, S, E);
        if (BOTH(6)) GRID_BAR();
    }
    if (IN(7)) {
        pg8::Gemm g{(const char*)(ws + WS_GATE), DM * 2, DM}; pg8::DenseOrder S; S.init(NTOK, DM, DM, F.G, (int)blockIdx.x, ws + WS_WO);
        EpiResid E{(const float*)args.in[0], (bf16_t*)(ws + WS_XMID)};
        pg8::gemm_phase(F.lds, g, S, E);
        if (BOTH(7)) GRID_BAR();
    }
    if (IN(8)) {
        auto w13_share = [&]() { LAS float* scr = (LAS float*)(F.lds + 40960 + F.wave * 8704); const int lane = F.lane;
            for (int r = F.vcu * NWAVES + F.wave; r < I_W13 - DEF_W13; r += F.G * NWAVES) p0_item_w13(args, ws, r, scr, lane); };
        if (F.vcu & 1) { w13_share(); __syncthreads(); p7_router(F, args); } else { p7_router(F, args); w13_share(); }
        if (BOTH(8)) GRID_BAR(); }
    if (IN(9)) {
        moe_sched_setup(F);
        pg8::Gemm g{(const char*)(ws + WS_XMID), DM * 2, DM};
        GroupOrder<true> S{(LAS const int*)(F.lds + MOE_LDS_OFF), F.G, F.vcu, (const char*)(ws + WS_W13), (size_t)1024 * DM * 2, (size_t)256 * DM * 2, (const int*)(ws + WS_TOKE)};
        EpiGlu E{(bf16_t*)(ws + WS_ACT), (const float*)(ws + WS_RSTDE)};
        pg8::gemm_phase(F.lds, g, S, E);
        { LAS float* scr = (LAS float*)(F.lds + F.wave * 16384); const int lane = F.lane;
          tail_items(F, F.vcu, (4 * S.sc[64]) % F.G, 0, I_W2, [&](int r) { p0_item_w2(args, ws, r, scr, lane); }); }
        if (BOTH(9)) GRID_BAR();
    }
    if (IN(10)) {
        moe_sched_setup(F);
        pg8::Gemm g{(const char*)(ws + WS_ACT), EFF * 2, EFF};
        GroupOrder<false> S{(LAS const int*)(F.lds + MOE_LDS_OFF), F.G, F.vcu, (const char*)(ws + WS_W2), (size_t)DM * EFF * 2, (size_t)256 * EFF * 2, nullptr};
        EpiScale E{(const float*)(ws + WS_GATEE), (bf16_t*)(ws + WS_Y)};
        pg8::gemm_phase(F.lds, g, S, E);
        if (BOTH(10)) GRID_BAR();
    }
    if (IN(11)) { moe_sched_setup(F); p10_combine(F, args); }
#undef IN
#undef BOTH
}

extern "C" void kernel_launch(void* const* d_in, const int* in_sizes, int n_in, void* d_out, int out_size, void* d_ws, size_t ws_size, hipStream_t stream) {
    static int grid = 0;
    if (grid == 0) {
        if (n_in != 24 || in_sizes[0] != NTOK * DM || out_size != NTOK * DM || ws_size < WS_END) { fprintf(stderr, "kernel_launch: unexpected shapes (n_in %d, in0 %d, out %d, ws %zu)\n", n_in, n_in > 0 ? in_sizes[0] : -1, out_size, ws_size); grid = -1; return; }
        int dev = 0, cus = 0, per_cu = 0;
        if (hipGetDevice(&dev) != hipSuccess || hipDeviceGetAttribute(&cus, hipDeviceAttributeMultiprocessorCount, dev) != hipSuccess) { grid = -1; return; }
        if (hipFuncSetAttribute((const void*)fwd_kernel, hipFuncAttributeMaxDynamicSharedMemorySize, LDS_BYTES) != hipSuccess) { fprintf(stderr, "kernel_launch: hipFuncSetAttribute failed\n"); grid = -1; return; }
        if (hipOccupancyMaxActiveBlocksPerMultiprocessor(&per_cu, (const void*)fwd_kernel, NWAVES * 64, LDS_BYTES) != hipSuccess || per_cu < 1) { fprintf(stderr, "kernel_launch: occupancy query says %d\n", per_cu); per_cu = 1; }
        (void)hipGetLastError();
        grid = cus;
        if (grid > 256) grid = 256;
    }
    if (grid < 0) return;
    (void)hipMemsetAsync((char*)d_ws + WS_CTL, 0, CTL_BYTES, stream);
    Args a{};
    for (int i = 0; i < 24; ++i) a.in[i] = d_in[i];
    a.out = (float*)d_out; a.ws = (unsigned char*)d_ws;
    if (MK_N_LAUNCHES == 1) { a.ph_lo = 0; a.ph_hi = N_PHASES; hipLaunchKernelGGL(fwd_kernel, dim3(grid), dim3(NWAVES * 64), LDS_BYTES, stream, a); }
    else for (int p = 0; p < N_PHASES; ++p) { a.ph_lo = p; a.ph_hi = p + 1; hipLaunchKernelGGL(fwd_kernel, dim3(grid), dim3(NWAVES * 64), LDS_BYTES, stream, a); }
}
```

```cpp
#include <hip/hip_runtime.h>
#include <cstdio>
#include <cstdint>

#define LAS __attribute__((address_space(3)))
#define GAS __attribute__((address_space(1)))
typedef unsigned short bf16_t;
typedef short bf16x8 __attribute__((ext_vector_type(8)));
typedef float f32x4 __attribute__((ext_vector_type(4)));
typedef float f32x2 __attribute__((ext_vector_type(2)));
typedef float f32x16 __attribute__((ext_vector_type(16)));
typedef unsigned u32x4 __attribute__((ext_vector_type(4)));
typedef unsigned u32x2 __attribute__((ext_vector_type(2)));

constexpr int DM = 1024, NB = 4, SEQ = 8192, NTOK = NB * SEQ;
constexpr int NH = 8, HD = 128, NKV = 2, KVW = NKV * HD;
constexpr int IH = 8, IDIM = 64, TOPK = 256, CHUNK = 64;
constexpr int NEXP = 32, EPG = 8, NGRP = 4, EFF = 512;
constexpr int IN_COLS = 6216, NP = 6400;
constexpr int NSLOT = (NTOK * 2 / 256 + NEXP) * 256;
constexpr float NORM_EPS = 1e-6f;

constexpr size_t MiB = 1u << 20;
constexpr size_t WS_CTL = 0, CTL_BYTES = 1 * MiB;
constexpr size_t WS_WG = 1 * MiB;
constexpr size_t WS_WR = 2 * MiB;
constexpr size_t WS_WIN = 4 * MiB;
constexpr size_t WS_WA = 17 * MiB, WS_WB = 19 * MiB, WS_WO = 21 * MiB;
constexpr size_t WS_W13 = 23 * MiB;
constexpr size_t WS_W2 = 87 * MiB;
constexpr size_t WS_ROPE = 119 * MiB;
constexpr size_t WS_WIDX = 125 * MiB;
constexpr size_t WS_KIDX = 126 * MiB;
constexpr size_t WS_LSUM = 130 * MiB;
constexpr size_t WS_TOKE = 134 * MiB;
constexpr size_t WS_GATEE = 138 * MiB;
constexpr size_t WS_TINFO = 142 * MiB;
constexpr size_t WS_XN = 144 * MiB;
constexpr size_t WS_Q = 208 * MiB;
constexpr size_t WS_K = 272 * MiB, WS_V = 288 * MiB;
constexpr size_t WS_QIDX = 304 * MiB;
constexpr size_t WS_MISC = 336 * MiB;
constexpr size_t WS_LRUX = 352 * MiB;
constexpr size_t WS_GATE = 416 * MiB;
constexpr size_t WS_Y = 144 * MiB;
constexpr size_t WS_ACT = 416 * MiB;
constexpr size_t WS_LIST = 488 * MiB;
constexpr size_t WS_V8 = 480 * MiB;
constexpr size_t WS_K8 = 504 * MiB;
constexpr size_t WS_RSTDE = 119 * MiB;
constexpr size_t WS_XMID = 288 * MiB;
constexpr size_t WS_END = 512 * MiB;
static_assert(WS_ACT + (size_t)NSLOT * EFF * 2 <= WS_END && WS_Y + (size_t)NSLOT * DM * 2 <= WS_V, "ws map");

constexpr int CW_TMO = 0;
constexpr int CW_BAR = 4096;
constexpr int CW_ECNT = 16384;

#define LDS_WAIT() asm volatile("s_waitcnt lgkmcnt(0)" ::: "memory")
#define VM_WAIT() asm volatile("s_waitcnt vmcnt(0)" ::: "memory")
#define RLX_AGENT __ATOMIC_RELAXED, __HIP_MEMORY_SCOPE_AGENT
__device__ __forceinline__ unsigned f2bf(float f) { unsigned u = __builtin_bit_cast(unsigned, f); return (u + 0x7fffu + ((u >> 16) & 1u)) >> 16; }
__device__ __forceinline__ unsigned pk2(float lo, float hi) { return f2bf(lo) | (f2bf(hi) << 16); }
__device__ __forceinline__ float bf2f(unsigned short b) { return __builtin_bit_cast(float, (unsigned)b << 16); }
__device__ __forceinline__ float bflo(unsigned w) { return __builtin_bit_cast(float, w << 16); }
__device__ __forceinline__ float bfhi(unsigned w) { return __builtin_bit_cast(float, w & 0xffff0000u); }
__device__ __forceinline__ float ubf0(unsigned w) { return (float)(w & 0xffu); }
__device__ __forceinline__ float ubf1(unsigned w) { return (float)((w >> 8) & 0xffu); }
__device__ __forceinline__ float ubf2(unsigned w) { return (float)((w >> 16) & 0xffu); }
__device__ __forceinline__ float ubf3(unsigned w) { return (float)(w >> 24); }
__device__ __forceinline__ unsigned cvt_pk_bf16(float lo, float hi) { unsigned r; asm volatile("v_cvt_pk_bf16_f32 %0, %1, %2" : "=v"(r) : "v"(lo), "v"(hi)); return r; }
__device__ __forceinline__ float fast_exp(float x) { return __builtin_amdgcn_exp2f(x * 1.4426950408889634f); }
__device__ __forceinline__ float fast_rcp(float x) { return __builtin_amdgcn_rcpf(x); }
__device__ __forceinline__ float sigmoidf_(float x) { return fast_rcp(1.0f + fast_exp(-x)); }
__device__ __forceinline__ float gelu_tanh(float x) {
    const float z = 0.7978845608028654f * (x + 0.044715f * x * x * x);
    return x * sigmoidf_(2.0f * z);
}
__device__ __forceinline__ float wave_sum(float v) {
#pragma unroll
    for (int o = 1; o < 64; o <<= 1) v += __shfl_xor(v, o);
    return v;
}

namespace pg8 {
constexpr int BM = 256, BK = 64, HALF = 128, HTB = HALF * BK * 2, STAGE_BYTES = 8 * HTB;
__host__ __device__ __forceinline__ int lds_byte(int r, int c) { const int st = (r >> 4) * 2 + (c >> 5), rr = r & 15, cc = c & 31, ob = rr * 64 + cc * 2; return st * 1024 + (ob ^ (((ob >> 9) & 1) << 5)); }
__host__ __device__ __forceinline__ void stage_rc(int b, int& R, int& C) { const int st = b / 1024, sb = b % 1024, swz = sb ^ (((sb >> 9) & 1) << 5); R = (st >> 1) * 16 + swz / 64; C = (st & 1) * 32 + (swz % 64) / 2; }
__host__ __device__ __forceinline__ int perm32(int rho) { const int n = rho >> 4, i = rho & 15; return 8 * (i >> 2) + 4 * n + (i & 3); }

struct Unit { const char* B; int pm, pn, aux; };
struct Gemm { const char* A; unsigned lda; int K; };

template <class Epi, class Sched>
__device__ __forceinline__ void gemm_phase(LAS unsigned char* lds, const Gemm g, const Sched& S, const Epi& E) {
    const int tid = threadIdx.x, wid = __builtin_amdgcn_readfirstlane(tid >> 6), lane = tid & 63, wr = wid >> 2, wc = wid & 3, fr = lane & 15, fq = lane >> 4;
    const int K = g.K, nt = K / BK;
    int Rr[2]; unsigned Cb[2], voffB[2];
#pragma unroll
    for (int i = 0; i < 2; ++i) { int R, C; stage_rc(tid * 16 + i * 8192, R, C); const int Rb = Epi::PERM ? ((R & ~31) + perm32(R & 31)) : R;
        Rr[i] = R; Cb[i] = (unsigned)C * 2u; voffB[i] = (unsigned)(Rb * K + C) * 2u; }
    const size_t kstep = (size_t)(BK * 2);
    const size_t hstepB = (size_t)HALF * K * 2;
    const unsigned ldsw = (unsigned)wid * 1024u;
    const int aoff = lds_byte(wr * 64 + fr, fq * 8), boff = lds_byte(wc * 32 + fr, fq * 8);
#define PG8_SA(b, h) (((b) * 2 + (h)) * HTB)
#define PG8_SB(b, h) ((4 + (b) * 2 + (h)) * HTB)
#define PG8_STAGE(bufoff, gbase, voff) do { _Pragma("unroll") for (int _i = 0; _i < 2; ++_i) \
        __builtin_amdgcn_global_load_lds((const unsigned*)((const char*)(gbase) + (voff)[_i]), (LAS unsigned*)(lds + (bufoff) + ldsw + _i * 8192), 16, 0, 0); } while (0)
#define PG8_LDA(dst, b, h) do { _Pragma("unroll") for (int m = 0; m < 4; ++m) _Pragma("unroll") for (int k = 0; k < 2; ++k) dst[m][k] = *(const LAS bf16x8*)(lds + PG8_SA(b, h) + aoff + m * 2048 + k * 1024); } while (0)
#define PG8_LDB(dst, b, h) do { _Pragma("unroll") for (int n = 0; n < 2; ++n) _Pragma("unroll") for (int k = 0; k < 2; ++k) dst[n][k] = *(const LAS bf16x8*)(lds + PG8_SB(b, h) + boff + n * 2048 + k * 1024); } while (0)
#define PG8_MMA(ai, bj, At, Bt) do { __builtin_amdgcn_s_setprio(1); _Pragma("unroll") for (int m = 0; m < 4; ++m) _Pragma("unroll") for (int n = 0; n < 2; ++n) _Pragma("unroll") for (int k = 0; k < 2; ++k) \
        acc[ai][bj][m][n] = __builtin_amdgcn_mfma_f32_16x16x32_bf16(Bt[n][k], At[m][k], acc[ai][bj][m][n], 0, 0, 0); __builtin_amdgcn_s_setprio(0); } while (0)
#define PG8_WAIT_V(n) asm volatile("s_waitcnt vmcnt(" #n ")" ::: "memory")
#define PG8_WAIT_L(n) asm volatile("s_waitcnt lgkmcnt(" #n ")" ::: "memory")
#define PG8_BAR __builtin_amdgcn_s_barrier()
#define PG8_SCHED __builtin_amdgcn_sched_barrier(0)
#define PG8_SETVA(dst, U) do { _Pragma("unroll") for (int _h = 0; _h < 2; ++_h) _Pragma("unroll") for (int _i = 0; _i < 2; ++_i) \
        dst[_h][_i] = (unsigned)S.arow(U, _h * HALF + Rr[_i]) * g.lda + Cb[_i]; } while (0)
    Unit cur, nxt; int ui = 0;
    if (!S.next(0, cur)) return;
    f32x4 acc[2][2][4][2];
#pragma unroll
    for (int a = 0; a < 2; ++a)
#pragma unroll
        for (int b = 0; b < 2; ++b)
#pragma unroll
            for (int m = 0; m < 4; ++m)
#pragma unroll
                for (int n = 0; n < 2; ++n) acc[a][b][m][n] = (f32x4){0.f, 0.f, 0.f, 0.f};
    bf16x8 At[4][2], B0[2][2], B1[2][2];
    unsigned vAc[2][2], vAn[2][2];
    PG8_SETVA(vAc, cur);
    const char* const gA = g.A;
    const char* cB = cur.B;
    PG8_STAGE(PG8_SB(0, 0), cB, voffB); PG8_STAGE(PG8_SB(0, 1), cB + hstepB, voffB); PG8_STAGE(PG8_SA(0, 0), gA, vAc[0]); PG8_STAGE(PG8_SA(0, 1), gA, vAc[1]);
    if (wr == 1) PG8_BAR;
    PG8_WAIT_V(2); PG8_BAR;
    PG8_STAGE(PG8_SB(1, 0), cB + kstep, voffB); PG8_STAGE(PG8_SA(1, 0), gA + kstep, vAc[0]); PG8_STAGE(PG8_SB(1, 1), cB + hstepB + kstep, voffB);
    PG8_WAIT_V(6); PG8_BAR;
    for (;;) {
        const bool has_next = S.next(ui + 1, nxt);
        if (has_next) { PG8_SETVA(vAn, nxt); } else { vAn[0][0] = vAc[0][0]; vAn[0][1] = vAc[0][1]; vAn[1][0] = vAc[1][0]; vAn[1][1] = vAc[1][1]; }
        const char* nB = has_next ? nxt.B : cB;
        for (int t = 0; t < nt; t += 2) {
            const bool last = (t == nt - 2);
            const char* a1 = gA + (size_t)(t + 1) * kstep;
            const char* a2 = gA + (size_t)(last ? 0 : (t + 2)) * kstep; const char* b2 = last ? nB : cB + (size_t)(t + 2) * kstep;
            const char* a3 = a2 + kstep; const char* b3 = b2 + kstep;
            unsigned v2[2][2];
            v2[0][0] = last ? vAn[0][0] : vAc[0][0]; v2[0][1] = last ? vAn[0][1] : vAc[0][1]; v2[1][0] = last ? vAn[1][0] : vAc[1][0]; v2[1][1] = last ? vAn[1][1] : vAc[1][1];
            PG8_LDB(B0, 0, 0); PG8_LDB(B1, 0, 1); PG8_SCHED; PG8_LDA(At, 0, 0); PG8_STAGE(PG8_SA(1, 1), a1, vAc[1]);
            PG8_WAIT_V(8); PG8_WAIT_L(0); PG8_BAR; PG8_MMA(0, 0, At, B0); PG8_MMA(0, 1, At, B1); PG8_BAR; PG8_SCHED;
            PG8_LDA(At, 0, 1); PG8_STAGE(PG8_SB(0, 0), b2, voffB); PG8_STAGE(PG8_SB(0, 1), b2 + hstepB, voffB); PG8_STAGE(PG8_SA(0, 0), a2, v2[0]);
            PG8_WAIT_V(8); PG8_WAIT_L(0); PG8_BAR; PG8_MMA(1, 0, At, B0); PG8_MMA(1, 1, At, B1); PG8_BAR; PG8_SCHED;
            PG8_LDB(B0, 1, 0); PG8_LDB(B1, 1, 1); PG8_SCHED; PG8_LDA(At, 1, 0); PG8_STAGE(PG8_SA(0, 1), a2, v2[1]);
            PG8_WAIT_V(8); PG8_WAIT_L(0); PG8_BAR; PG8_MMA(0, 0, At, B0); PG8_MMA(0, 1, At, B1); PG8_BAR; PG8_SCHED;
            PG8_LDA(At, 1, 1); PG8_STAGE(PG8_SB(1, 0), b3, voffB); PG8_STAGE(PG8_SB(1, 1), b3 + hstepB, voffB); PG8_STAGE(PG8_SA(1, 0), a3, v2[0]);
            PG8_WAIT_V(8); PG8_WAIT_L(0); PG8_BAR; PG8_MMA(1, 0, At, B0); PG8_MMA(1, 1, At, B1); PG8_BAR; PG8_SCHED;
        }
        if (wr == 0) PG8_BAR;
        E(acc, cur, wr, wc, fr, fq);
        if (!has_next) break;
#pragma unroll
        for (int a = 0; a < 2; ++a)
#pragma unroll
            for (int b = 0; b < 2; ++b)
#pragma unroll
                for (int m = 0; m < 4; ++m)
#pragma unroll
                    for (int n = 0; n < 2; ++n) acc[a][b][m][n] = (f32x4){0.f, 0.f, 0.f, 0.f};
        cur = nxt; cB = nB; ++ui;
        vAc[0][0] = vAn[0][0]; vAc[0][1] = vAn[0][1]; vAc[1][0] = vAn[1][0]; vAc[1][1] = vAn[1][1];
        if (wr == 1) PG8_BAR;
    }
    PG8_WAIT_V(0);
    PG8_BAR;
#undef PG8_SA
#undef PG8_SB
#undef PG8_STAGE
#undef PG8_LDA
#undef PG8_LDB
#undef PG8_MMA
#undef PG8_WAIT_V
#undef PG8_WAIT_L
#undef PG8_BAR
#undef PG8_SCHED
#undef PG8_SETVA
}

struct DenseOrder {
    int nM, nN, nwg, G, c; const char* Bt; size_t tstepB;
    __device__ void init(int M, int N, int K, int G_, int c_, const void* Bt_) { nM = M / BM; nN = N / BM; nwg = nM * nN; G = G_; c = c_; Bt = (const char*)Bt_; tstepB = (size_t)BM * K * 2; }
    __device__ __forceinline__ bool next(int i, Unit& u) const {
        const long L = (long)i * G + c; if (L >= nwg) return false;
        int wgid = (int)L; { const int q = nwg / 8, r = nwg % 8, xcd = wgid % 8, off = wgid / 8; wgid = (xcd < r ? xcd * (q + 1) : r * (q + 1) + (xcd - r) * q) + off; }
        const int nig = 8 * nN, gid = wgid / nig, fm = gid * 8, gsz = (nM - fm) < 8 ? (nM - fm) : 8;
        u.pm = fm + ((wgid % nig) % gsz); u.pn = (wgid % nig) / gsz; u.aux = 0; u.B = Bt + (size_t)u.pn * tstepB; return true;
    }
    __device__ __forceinline__ int arow(const Unit& u, int r) const { return u.pm * BM + r; }
};
}

using pg8::Unit;
__device__ __forceinline__ unsigned fp8x4(float a, float b, float c, float d);
struct EpiProj {
    static constexpr bool PERM = true;
    unsigned char* ws; unsigned char* dout;
    __device__ __forceinline__ void operator()(const f32x4 (&acc)[2][2][4][2], const Unit& u, int wr, int wc, int fr, int fq) const {
        const int pn = u.pn; bf16_t* base; int ldc, colt, act = 0;
        if (pn < 4)       { base = (bf16_t*)(ws + WS_LRUX); ldc = DM;   colt = pn * 256; }
        else if (pn < 8)  { base = (bf16_t*)(ws + WS_GATE); ldc = DM;   colt = (pn - 4) * 256; act = 1; }
        else if (pn < 12) { base = (bf16_t*)(ws + WS_Q);    ldc = DM;   colt = (pn - 8) * 256; }
        else if (pn == 12){ base = (bf16_t*)(ws + WS_K);    ldc = KVW;  colt = 0; }
        else if (pn == 13){ base = (bf16_t*)(ws + WS_V);    ldc = KVW;  colt = 0; }
        else if (pn < 16) { base = (bf16_t*)(ws + WS_QIDX); ldc = 512;  colt = (pn - 14) * 256; }
        else if (pn < 24) { base = (bf16_t*)dout;           ldc = 2048; colt = (pn - 16) * 256; act = 2; }
        else              { base = (bf16_t*)(ws + WS_MISC); ldc = 256;  colt = 0; }
        const int row0 = u.pm * 256 + wr * 64 + fr, col0 = colt + wc * 32 + 8 * fq;
#pragma unroll
        for (int ai = 0; ai < 2; ++ai)
#pragma unroll
            for (int m = 0; m < 4; ++m) { bf16_t* rowp = base + (size_t)(row0 + ai * 128 + m * 16) * ldc + col0;
#pragma unroll
                for (int bj = 0; bj < 2; ++bj) { f32x4 v0 = acc[ai][bj][m][0], v1 = acc[ai][bj][m][1];
                    if (pn == 13) {
                        u32x2 w8; w8.x = fp8x4(v0[0], v0[1], v0[2], v0[3]); w8.y = fp8x4(v1[0], v1[1], v1[2], v1[3]);
                        *(u32x2*)(ws + WS_V8 + (size_t)(row0 + ai * 128 + m * 16) * 256 + wc * 32 + 8 * fq + bj * 128) = w8; continue; }
                    if (act == 1) {
#pragma unroll
                        for (int e = 0; e < 4; ++e) { v0[e] = gelu_tanh(v0[e]); v1[e] = gelu_tanh(v1[e]); } }
                    else if (act == 2) {
                        unsigned w0 = 0u, w1 = 0u;
#pragma unroll
                        for (int e = 0; e < 4; ++e) { w0 = (unsigned)__builtin_amdgcn_cvt_pk_u8_f32(sigmoidf_(v0[e]) * 256.0f, e, w0); w1 = (unsigned)__builtin_amdgcn_cvt_pk_u8_f32(sigmoidf_(v1[e]) * 256.0f, e, w1); }
                        u32x2 w8; w8.x = w0; w8.y = w1;
                        __builtin_nontemporal_store(w8, (u32x2*)(dout + (size_t)(row0 + ai * 128 + m * 16) * 2048 + col0 + bj * 128)); continue; }
                    u32x4 w; w.x = cvt_pk_bf16(v0[0], v0[1]); w.y = cvt_pk_bf16(v0[2], v0[3]); w.z = cvt_pk_bf16(v1[0], v1[1]); w.w = cvt_pk_bf16(v1[2], v1[3]);
                    __builtin_nontemporal_store(w, (u32x4*)(rowp + bj * 128)); } }
    }
};
template <bool ADD> struct EpiMerge {
    static constexpr bool PERM = true;
    const unsigned char* sig; int sigoff; const bf16_t* prev; bf16_t* O;
    __device__ __forceinline__ void operator()(const f32x4 (&acc)[2][2][4][2], const Unit& u, int wr, int wc, int fr, int fq) const {
        const int row0 = u.pm * 256 + wr * 64 + fr, col0 = u.pn * 256 + wc * 32 + 8 * fq;
#pragma unroll
        for (int ai = 0; ai < 2; ++ai) {
            u32x2 sg[4][2]; u32x4 pv[4][2];
#pragma unroll
            for (int m = 0; m < 4; ++m)
#pragma unroll
                for (int bj = 0; bj < 2; ++bj) { const size_t row = (size_t)(row0 + ai * 128 + m * 16); const int col = col0 + bj * 128;
                    sg[m][bj] = __builtin_nontemporal_load((const u32x2*)(sig + row * 2048 + sigoff + col));
                    if (ADD) pv[m][bj] = __builtin_nontemporal_load((const u32x4*)(prev + row * DM + col)); }
            asm volatile("" ::: "memory");
#pragma unroll
            for (int m = 0; m < 4; ++m)
#pragma unroll
                for (int bj = 0; bj < 2; ++bj) { const size_t row = (size_t)(row0 + ai * 128 + m * 16); const int col = col0 + bj * 128;
                    const u32x2 g = sg[m][bj];
                    f32x4 v0 = acc[ai][bj][m][0] * 0.00390625f, v1 = acc[ai][bj][m][1] * 0.00390625f;
                    v0[0] *= ubf0(g.x); v0[1] *= ubf1(g.x); v0[2] *= ubf2(g.x); v0[3] *= ubf3(g.x);
                    v1[0] *= ubf0(g.y); v1[1] *= ubf1(g.y); v1[2] *= ubf2(g.y); v1[3] *= ubf3(g.y);
                    if (ADD) { const u32x4 q = pv[m][bj];
                        v0[0] += bflo(q.x); v0[1] += bfhi(q.x); v0[2] += bflo(q.y); v0[3] += bfhi(q.y);
                        v1[0] += bflo(q.z); v1[1] += bfhi(q.z); v1[2] += bflo(q.w); v1[3] += bfhi(q.w); }
                    u32x4 w; w.x = cvt_pk_bf16(v0[0], v0[1]); w.y = cvt_pk_bf16(v0[2], v0[3]); w.z = cvt_pk_bf16(v1[0], v1[1]); w.w = cvt_pk_bf16(v1[2], v1[3]);
                    *(u32x4*)(O + row * DM + col) = w; }
        }
    }
};
struct EpiResid {
    static constexpr bool PERM = true;
    const float* x; bf16_t* xmid;
    __device__ __forceinline__ void operator()(const f32x4 (&acc)[2][2][4][2], const Unit& u, int wr, int wc, int fr, int fq) const {
        const int row0 = u.pm * 256 + wr * 64 + fr, col0 = u.pn * 256 + wc * 32 + 8 * fq;
#pragma unroll
        for (int ai = 0; ai < 2; ++ai) {
            f32x4 xv[4][2][2];
#pragma unroll
            for (int m = 0; m < 4; ++m)
#pragma unroll
                for (int bj = 0; bj < 2; ++bj) { const size_t off = (size_t)(row0 + ai * 128 + m * 16) * DM + col0 + bj * 128;
                    xv[m][bj][0] = __builtin_nontemporal_load((const f32x4*)(x + off)); xv[m][bj][1] = __builtin_nontemporal_load((const f32x4*)(x + off + 4)); }
            asm volatile("" ::: "memory");
#pragma unroll
            for (int m = 0; m < 4; ++m)
#pragma unroll
                for (int bj = 0; bj < 2; ++bj) { const size_t off = (size_t)(row0 + ai * 128 + m * 16) * DM + col0 + bj * 128;
                    const f32x4 v0 = xv[m][bj][0] + acc[ai][bj][m][0], v1 = xv[m][bj][1] + acc[ai][bj][m][1];
                    u32x4 w; w.x = cvt_pk_bf16(v0[0], v0[1]); w.y = cvt_pk_bf16(v0[2], v0[3]); w.z = cvt_pk_bf16(v1[0], v1[1]); w.w = cvt_pk_bf16(v1[2], v1[3]);
                    *(u32x4*)(xmid + off) = w; }
        }
    }
};
struct EpiGlu {
    static constexpr bool PERM = true;
    bf16_t* act; const float* rstdE;
    __device__ __forceinline__ void operator()(const f32x4 (&acc)[2][2][4][2], const Unit& u, int wr, int wc, int fr, int fq) const {
        const int row0 = u.pm * 256 + wr * 64 + fr, col0 = u.pn * 128 + wc * 32 + 8 * fq;
        const float* rp = rstdE + (size_t)(u.aux >> 7) * NTOK + (u.aux & 127) * 256 + wr * 64 + fr;
        float rsv[2][4];
#pragma unroll
        for (int ai = 0; ai < 2; ++ai)
#pragma unroll
            for (int m = 0; m < 4; ++m) rsv[ai][m] = rp[ai * 128 + m * 16];
        asm volatile("" ::: "memory");
#pragma unroll
        for (int ai = 0; ai < 2; ++ai)
#pragma unroll
            for (int m = 0; m < 4; ++m) { const size_t row = (size_t)(row0 + ai * 128 + m * 16); const float rs = rsv[ai][m];
                f32x4 v0, v1;
#pragma unroll
                for (int e = 0; e < 4; ++e) { const float g0 = acc[ai][0][m][0][e] * rs, g1 = acc[ai][0][m][1][e] * rs;
                    v0[e] = g0 * sigmoidf_(g0) * (acc[ai][1][m][0][e] * rs); v1[e] = g1 * sigmoidf_(g1) * (acc[ai][1][m][1][e] * rs); }
                u32x4 w; w.x = cvt_pk_bf16(v0[0], v0[1]); w.y = cvt_pk_bf16(v0[2], v0[3]); w.z = cvt_pk_bf16(v1[0], v1[1]); w.w = cvt_pk_bf16(v1[2], v1[3]);
                *(u32x4*)(act + row * EFF + col0) = w; }
    }
};
struct EpiScale {
    static constexpr bool PERM = true;
    const float* gateE; bf16_t* y;
    __device__ __forceinline__ void operator()(const f32x4 (&acc)[2][2][4][2], const Unit& u, int wr, int wc, int fr, int fq) const {
        const int e = u.aux >> 7, j = u.aux & 127;
        const float* gp = gateE + (size_t)e * NTOK + j * 256;
        const int rl0 = wr * 64 + fr, col0 = u.pn * 256 + wc * 32 + 8 * fq;
        float gtv[2][4];
#pragma unroll
        for (int ai = 0; ai < 2; ++ai)
#pragma unroll
            for (int m = 0; m < 4; ++m) gtv[ai][m] = gp[rl0 + ai * 128 + m * 16];
        asm volatile("" ::: "memory");
#pragma unroll
        for (int ai = 0; ai < 2; ++ai)
#pragma unroll
            for (int m = 0; m < 4; ++m) { const int rl = rl0 + ai * 128 + m * 16; const float gt = gtv[ai][m]; const size_t row = (size_t)(u.pm * 256 + rl);
#pragma unroll
                for (int bj = 0; bj < 2; ++bj) { const f32x4 v0 = acc[ai][bj][m][0] * gt, v1 = acc[ai][bj][m][1] * gt;
                    u32x4 w; w.x = cvt_pk_bf16(v0[0], v0[1]); w.y = cvt_pk_bf16(v0[2], v0[3]); w.z = cvt_pk_bf16(v1[0], v1[1]); w.w = cvt_pk_bf16(v1[2], v1[3]);
                    *(u32x4*)(y + row * DM + col0 + bj * 128) = w; } }
    }
};

typedef GAS unsigned gu32;
#define XB_TMO      128
#define XB_XCNT(j)  (256  + 64 * (j))
#define XB_XSUB(j)  (1280 + 64 * (j))
#define XB_XGEN(j)  (2304 + 64 * (j))
#define XB_TOP      3328
#define XB_TOPGEN   3392
#define XCD_BAR_WORDS 3456
#define XB_SPIN_CAP (1u << 18)
__device__ __forceinline__ unsigned xb_ld(unsigned* p)              { return __hip_atomic_load(p, __ATOMIC_RELAXED, __HIP_MEMORY_SCOPE_AGENT); }
__device__ __forceinline__ unsigned xb_add(unsigned* p, unsigned v) { return __hip_atomic_fetch_add(p, v, __ATOMIC_RELAXED, __HIP_MEMORY_SCOPE_AGENT); }
__device__ __forceinline__ unsigned xb_xcc_id() { return (unsigned)__builtin_amdgcn_s_getreg((3 << 11) | 20) & 0xFu; }
#define XB_SPIN(cond, bar) do { unsigned _sp = 0; while (cond) { __builtin_amdgcn_s_sleep(1); \
    if ((++_sp & 255u) == 0u) { if (xb_ld(&(bar)[XB_TMO])) break; if (_sp > XB_SPIN_CAP) { atomicAdd(&(bar)[XB_TMO], 1u); break; } } } } while (0)
struct XcdBarrier { unsigned* bar; unsigned x; volatile LAS unsigned* st; };
__device__ __forceinline__ XcdBarrier xcd_barrier_post(unsigned* bar, volatile LAS unsigned* st) {
    XcdBarrier b; b.bar = bar; b.x = xb_xcc_id(); b.st = st;
    if (threadIdx.x == 0) (void)xb_add(&bar[XB_XCNT(b.x)], 1u);
    return b;
}
__device__ __forceinline__ void xcd_barrier_complete(unsigned* bar, unsigned x, unsigned& nloc, unsigned& nx) {
    const unsigned G = gridDim.x * gridDim.y * gridDim.z;
    unsigned sum, cnt, mine, sp = 0u;
    for (;;) {
        sum = 0u; cnt = 0u; mine = 0u;
#pragma unroll
        for (unsigned j = 0; j < 16; ++j) { const unsigned c = xb_ld(&bar[XB_XCNT(j)]); sum += c; cnt += (c > 0u) ? 1u : 0u; mine = (j == x) ? c : mine; }
        if (sum == G) break;
        __builtin_amdgcn_s_sleep(1);
        if ((++sp & 255u) == 0u) { if (xb_ld(&bar[XB_TMO])) break; if (sp > XB_SPIN_CAP) { atomicAdd(&bar[XB_TMO], 1u); break; } }
    }
    nloc = mine > 0u ? mine : 1u; nx = cnt > 0u ? cnt : 1u;
}
__device__ __forceinline__ void xcd_barrier(const XcdBarrier& b) {
    asm volatile("s_waitcnt vmcnt(0)" ::: "memory");
    __syncthreads();
    if (threadIdx.x == 0) {
        unsigned* bar = b.bar;
        __builtin_amdgcn_s_waitcnt(0);
        unsigned nloc = b.st[0], nx = b.st[1];
        if (nloc == 0u) { xcd_barrier_complete(bar, b.x, nloc, nx); b.st[0] = nloc; b.st[1] = nx; }
        const unsigned old = xb_add(&bar[XB_XSUB(b.x)], 1u);
        const unsigned gen = old / nloc;
        if (old + 1u == (gen + 1u) * nloc) {
            __builtin_amdgcn_fence(__ATOMIC_RELEASE, "agent");
            asm volatile("s_waitcnt vmcnt(0)" ::: "memory");
            const unsigned og = xb_add(&bar[XB_TOP], 1u);
            const unsigned tg = og / nx;
            if (og + 1u == (tg + 1u) * nx) xb_add(&bar[XB_TOPGEN], 1u);
            else XB_SPIN(xb_ld(&bar[XB_TOPGEN]) == tg, bar);
            __builtin_amdgcn_fence(__ATOMIC_ACQUIRE, "agent");
            xb_add(&bar[XB_XGEN(b.x)], 1u);
            asm volatile("s_waitcnt vmcnt(0)" ::: "memory");
        } else {
            XB_SPIN(xb_ld(&bar[XB_XGEN(b.x)]) == gen, bar);
            __builtin_amdgcn_fence(__ATOMIC_ACQUIRE, "agent");
            asm volatile("s_waitcnt vmcnt(0)" ::: "memory");
        }
    }
    __syncthreads();
}

constexpr int NWAVES = 8;
constexpr int RING_BYTES = 131072, LDSCTL_OFF = 147456, MISC_OFF = LDSCTL_OFF + 320, LDS_BYTES = 151552;
constexpr int N_PHASES = 12;
#ifndef MK_N_LAUNCHES
#define MK_N_LAUNCHES 1
#endif
struct Args { const void* in[24]; float* out; unsigned char* ws; int ph_lo, ph_hi; };
struct Frame {
    LAS unsigned char* lds; volatile LAS unsigned* MISC; unsigned* ctl; unsigned char* ws; unsigned char* q8;
    int tid, lane, wave, vcu, G;
};

template <class CMap>
__device__ __forceinline__ void p0_transpose_item(const float* W, int ldw, bf16_t* WT, int Kd, LAS float* scr, int kb, int nb, int lane, const CMap& cmap, const float* ksc = nullptr) {
    const int k0 = 64 * kb, n0 = 32 * nb;
    const int kr = lane >> 3, nq = lane & 7; const int sc = cmap(n0 + 4 * nq);
    f32x4 v[8];
#pragma unroll
    for (int i = 0; i < 8; ++i) v[i] = sc >= 0 ? __builtin_nontemporal_load((const f32x4*)(W + (size_t)(k0 + 8 * i + kr) * ldw + sc)) : (f32x4){0.f, 0.f, 0.f, 0.f};
#pragma unroll
    for (int i = 0; i < 8; ++i) { LAS float* d = scr + (8 * i + kr) * 33 + 4 * nq; d[0] = v[i].x; d[1] = v[i].y; d[2] = v[i].z; d[3] = v[i].w; }
    LDS_WAIT(); asm volatile("" ::: "memory");
    const int c = lane & 7;
    f32x4 g0 = (f32x4){1.f, 1.f, 1.f, 1.f}, g1 = g0;
    if (ksc) { g0 = *(const f32x4*)(ksc + k0 + 8 * c); g1 = *(const f32x4*)(ksc + k0 + 8 * c + 4); }
#pragma unroll
    for (int j = 0; j < 4; ++j) { const int n = (lane >> 3) + 8 * j; const LAS float* s = scr + (8 * c) * 33 + n;
        u32x4 o; o.x = pk2(s[0 * 33] * g0.x, s[1 * 33] * g0.y); o.y = pk2(s[2 * 33] * g0.z, s[3 * 33] * g0.w); o.z = pk2(s[4 * 33] * g1.x, s[5 * 33] * g1.y); o.w = pk2(s[6 * 33] * g1.z, s[7 * 33] * g1.w);
        *(GAS u32x4*)(WT + (size_t)(n0 + n) * Kd + k0 + 8 * c) = o; }
    LDS_WAIT(); asm volatile("" ::: "memory");
}
struct CMapId { __device__ __forceinline__ int operator()(int n) const { return n; } };
struct CMapWin {
    __device__ __forceinline__ int operator()(int n) const { return n < 4096 ? n : n < 6144 ? 4168 + (n - 4096) : n < 6208 ? 4096 + (n - 6144) : n < 6216 ? 4160 + (n - 6208) : -1; } };
struct CMapW13 {
    __device__ __forceinline__ int operator()(int n) const { const int pn = n >> 8, bj = (n >> 7) & 1, j = n & 127; return 512 * bj + 128 * pn + j; } };

constexpr int I_WIN = 16 * (NP / 32), I_SQ = 16 * 32, I_W13 = 32 * 16 * 32, I_W2 = 32 * 8 * 32, I_G = 16 * 2 * 4;
constexpr int DEF_W13 = 5120;
__device__ __forceinline__ void p0_item_w13(const Args& a, unsigned char* ws, int r, LAS float* scr, int lane) {
    const int e = r / 512, q = r % 512;
    p0_transpose_item((const float*)a.in[22] + (size_t)e * DM * 1024, 1024, (bf16_t*)(ws + WS_W13) + (size_t)e * 1024 * DM, DM, scr, q / 32, q % 32, lane, CMapW13(), (const float*)a.in[17]);
}
__device__ __forceinline__ void p0_item_w2(const Args& a, unsigned char* ws, int r, LAS float* scr, int lane) {
    const int e = r / 256, q = r % 256;
    p0_transpose_item((const float*)a.in[23] + (size_t)e * EFF * DM, DM, (bf16_t*)(ws + WS_W2) + (size_t)e * DM * EFF, EFF, scr, q / 32, q % 32, lane, CMapId());
}
template <class Fn> __device__ __forceinline__ void tail_items(const Frame& F, int c, int rem, int lo, int hi, const Fn& fn) {
    const int nid = rem ? F.G - rem : F.G, idx = rem ? c - rem : c;
    if (idx < 0) return;
    for (int r = lo + idx * NWAVES + F.wave; r < hi; r += nid * NWAVES) fn(r);
}
__device__ __forceinline__ void p0_prologue(Frame& F, const Args& a) {
    LAS float* scr = (LAS float*)(F.lds + F.wave * 16384);
    const int gw = F.vcu * NWAVES + F.wave, NGW = F.G * NWAVES, lane = F.lane;
    unsigned char* ws = F.ws;
    constexpr int NITEMS = I_WIN + 3 * I_SQ + I_G;
    for (int it = gw; it < NITEMS; it += NGW) {
        int r = it;
        if (r < I_WIN) { p0_transpose_item((const float*)a.in[3], IN_COLS, (bf16_t*)(ws + WS_WIN), DM, scr, r / (NP / 32), r % (NP / 32), lane, CMapWin()); continue; } r -= I_WIN;
        if (r < I_SQ) { p0_transpose_item((const float*)a.in[14], DM, (bf16_t*)(ws + WS_WA), DM, scr, r / 32, r % 32, lane, CMapId()); continue; } r -= I_SQ;
        if (r < I_SQ) { p0_transpose_item((const float*)a.in[15], DM, (bf16_t*)(ws + WS_WB), DM, scr, r / 32, r % 32, lane, CMapId()); continue; } r -= I_SQ;
        if (r < I_SQ) { p0_transpose_item((const float*)a.in[16], DM, (bf16_t*)(ws + WS_WO), DM, scr, r / 32, r % 32, lane, CMapId()); continue; } r -= I_SQ;
        { const int blk = r >> 3, q = r & 7, gate = blk & 1, n = blk >> 1;
          const float* src = (const float*)(gate ? a.in[8] : a.in[6]) + (size_t)n * 128 * 128;
          p0_transpose_item(src, 128, (bf16_t*)(ws + WS_WG) + (size_t)blk * 128 * 128, 128, scr, q >> 2, q & 3, lane, CMapId()); }
    }
    const float* x = (const float*)a.in[0]; const float* g1 = (const float*)a.in[2];
    f32x4 gv[4];
#pragma unroll
    for (int j = 0; j < 4; ++j) gv[j] = ((const f32x4*)g1)[lane + 64 * j];
    if (gw < NTOK) {
        f32x4 v[4];
#pragma unroll
        for (int j = 0; j < 4; ++j) v[j] = __builtin_nontemporal_load(((const GAS f32x4*)(x + (size_t)gw * DM) + lane) + 64 * j);
        for (int m = gw; m < NTOK; m += NGW) {
            const int mn = m + NGW < NTOK ? m + NGW : m; f32x4 vn[4];
#pragma unroll
            for (int j = 0; j < 4; ++j) vn[j] = __builtin_nontemporal_load(((const GAS f32x4*)(x + (size_t)mn * DM) + lane) + 64 * j);
            float s = 0.f;
#pragma unroll
            for (int j = 0; j < 4; ++j) s += (v[j].x * v[j].x + v[j].y * v[j].y) + (v[j].z * v[j].z + v[j].w * v[j].w);
            const float rstd = 1.0f / sqrtf(wave_sum(s) * (1.f / DM) + NORM_EPS);
            GAS u32x2* o8 = (GAS u32x2*)((bf16_t*)(ws + WS_XN) + (size_t)m * DM) + lane;
#pragma unroll
            for (int j = 0; j < 4; ++j) { u32x2 o; o.x = pk2(v[j].x * rstd * gv[j].x, v[j].y * rstd * gv[j].y); o.y = pk2(v[j].z * rstd * gv[j].z, v[j].w * rstd * gv[j].w); o8[64 * j] = o; }
#pragma unroll
            for (int j = 0; j < 4; ++j) v[j] = vn[j];
        }
    }
    { const int* pos = (const int*)a.in[1]; float* rope = (float*)(ws + WS_ROPE);
      const int gt = (F.vcu * NWAVES + F.wave) * 64 + lane, NGT = NGW * 64;
      for (int i = gt; i < NTOK * 24; i += NGT) { const int t = i / 24, f = i % 24; const float p = (float)pos[t];
          if (f < 16) { const float inv = powf(500000.0f, -(float)(2 * f) / 32.0f); const float ang = p * inv; rope[(size_t)t * 16 + f] = cosf(ang); rope[(size_t)NTOK * 16 + (size_t)t * 16 + f] = sinf(ang); }
          else { const int f2 = f - 16; const float inv = powf(500000.0f, -(float)(2 * f2) / 16.0f); const float ang = p * inv; rope[(size_t)NTOK * 32 + (size_t)t * 8 + f2] = cosf(ang); rope[(size_t)NTOK * 40 + (size_t)t * 8 + f2] = sinf(ang); } }
      const float* g2 = (const float*)a.in[17]; const float* wg = (const float*)a.in[18]; const float* we = (const float*)a.in[20]; float* wrt = (float*)(ws + WS_WR);
      for (int i = gt; i < 36 * DM; i += NGT) { const int c = i / DM, k = i % DM; wrt[i] = g2[k] * (c < 4 ? wg[k * 4 + c] : we[k * 32 + (c - 4)]); } }
}

template <int EPL, bool NORM>
__device__ __forceinline__ void norm_rope_regs(float (&x)[EPL], const f32x4 (&g)[EPL / 4], const float (&cs)[EPL], const float (&sn)[EPL], float scale, int lane) {
    const int hl = lane & 7;
    if (NORM) { float ss = 0.f;
#pragma unroll
        for (int e = 0; e < EPL; ++e) ss += x[e] * x[e];
        ss += __shfl_xor(ss, 1); ss += __shfl_xor(ss, 2); ss += __shfl_xor(ss, 4);
        const float rstd = 1.0f / sqrtf(ss * (1.0f / (8 * EPL)) + NORM_EPS);
#pragma unroll
        for (int e = 0; e < EPL; e += 4) { const f32x4 gv = g[e / 4]; x[e] *= rstd * gv.x; x[e + 1] *= rstd * gv.y; x[e + 2] *= rstd * gv.z; x[e + 3] *= rstd * gv.w; } }
#pragma unroll
    for (int e = 0; e < EPL; ++e) { const float p = __shfl_xor(x[e], 1); const float c = cs[e], sv = sn[e];
        const float r0 = x[e] * c - p * sv, r1 = x[e] * c + p * sv; x[e] = (hl == 0 ? r0 : hl == 1 ? r1 : x[e]) * scale; }
}
__device__ __forceinline__ unsigned fp8x4(float a, float b, float c, float d) { int r = __builtin_amdgcn_cvt_pk_fp8_f32(a, b, 0, false); r = __builtin_amdgcn_cvt_pk_fp8_f32(c, d, r, true); return (unsigned)r; }
__device__ __forceinline__ void unpk8(const u32x4 a, float* x) { x[0] = bflo(a.x); x[1] = bfhi(a.x); x[2] = bflo(a.y); x[3] = bfhi(a.y); x[4] = bflo(a.z); x[5] = bfhi(a.z); x[6] = bflo(a.w); x[7] = bfhi(a.w); }
__device__ __forceinline__ u32x4 pk8(const float* x) { u32x4 a; a.x = pk2(x[0], x[1]); a.y = pk2(x[2], x[3]); a.z = pk2(x[4], x[5]); a.w = pk2(x[6], x[7]); return a; }
constexpr float QSCALE = 0.08838834764831845f * 1.4426950408889634f;
struct PPTok { u32x4 q0, q1, k0, k1, qi, ki; f32x4 cm[4], sm[4], ci[2], si[2]; unsigned wr; };
__device__ __forceinline__ void pp_load(PPTok& T, unsigned char* ws, int t, int lane) {
    const float* rope = (const float*)(ws + WS_ROPE);
    const bf16_t* q = (const bf16_t*)(ws + WS_Q) + (size_t)t * DM + lane * 16; T.q0 = __builtin_nontemporal_load((const u32x4*)q); T.q1 = __builtin_nontemporal_load((const u32x4*)(q + 8));
    const bf16_t* k = (const bf16_t*)(ws + WS_K) + (size_t)t * KVW + (lane & 15) * 16; T.k0 = __builtin_nontemporal_load((const u32x4*)k); T.k1 = __builtin_nontemporal_load((const u32x4*)(k + 8));
    T.qi = __builtin_nontemporal_load((const u32x4*)((const bf16_t*)(ws + WS_QIDX) + (size_t)t * 512 + lane * 8));
    const bf16_t* ms = (const bf16_t*)(ws + WS_MISC) + (size_t)t * 256; T.ki = *(const u32x4*)(ms + (lane & 7) * 8); T.wr = ms[64 + (lane & 7)];
#pragma unroll
    for (int i = 0; i < 4; ++i) { T.cm[i] = *(const f32x4*)(rope + (size_t)t * 16 + 4 * i); T.sm[i] = *(const f32x4*)(rope + (size_t)NTOK * 16 + (size_t)t * 16 + 4 * i); }
#pragma unroll
    for (int i = 0; i < 2; ++i) { T.ci[i] = *(const f32x4*)(rope + (size_t)NTOK * 32 + (size_t)t * 8 + 4 * i); T.si[i] = *(const f32x4*)(rope + (size_t)NTOK * 40 + (size_t)t * 8 + 4 * i); }
}
struct PPGain { f32x4 q[4], k[4], i[2]; };
__device__ __forceinline__ void pp_finish(const PPTok& T, const PPGain& G, unsigned char* ws, unsigned char* q8, int t, int lane) {
    float cm[16], sm[16], ci[8], si[8];
#pragma unroll
    for (int i = 0; i < 4; ++i) { cm[4 * i] = T.cm[i].x; cm[4 * i + 1] = T.cm[i].y; cm[4 * i + 2] = T.cm[i].z; cm[4 * i + 3] = T.cm[i].w; sm[4 * i] = T.sm[i].x; sm[4 * i + 1] = T.sm[i].y; sm[4 * i + 2] = T.sm[i].z; sm[4 * i + 3] = T.sm[i].w; }
#pragma unroll
    for (int i = 0; i < 2; ++i) { ci[4 * i] = T.ci[i].x; ci[4 * i + 1] = T.ci[i].y; ci[4 * i + 2] = T.ci[i].z; ci[4 * i + 3] = T.ci[i].w; si[4 * i] = T.si[i].x; si[4 * i + 1] = T.si[i].y; si[4 * i + 2] = T.si[i].z; si[4 * i + 3] = T.si[i].w; }
    { float x[16]; unpk8(T.q0, x); unpk8(T.q1, x + 8); norm_rope_regs<16, true>(x, G.q, cm, sm, 1.0f, lane);
      u32x4 o; o.x = fp8x4(x[0], x[1], x[2], x[3]); o.y = fp8x4(x[4], x[5], x[6], x[7]); o.z = fp8x4(x[8], x[9], x[10], x[11]); o.w = fp8x4(x[12], x[13], x[14], x[15]);
      *(u32x4*)(q8 + (size_t)t * DM + lane * 16) = o; }
    { float x[16]; unpk8(T.k0, x); unpk8(T.k1, x + 8); norm_rope_regs<16, true>(x, G.k, cm, sm, 1.0f, lane);
      if (lane < 16) { u32x4 o; o.x = fp8x4(x[0], x[1], x[2], x[3]); o.y = fp8x4(x[4], x[5], x[6], x[7]); o.z = fp8x4(x[8], x[9], x[10], x[11]); o.w = fp8x4(x[12], x[13], x[14], x[15]);
          *(u32x4*)(ws + WS_K8 + (size_t)t * 256 + lane * 16) = o; } }
    { float x[8]; unpk8(T.qi, x); norm_rope_regs<8, false>(x, G.i, ci, si, 1.0f, lane); *(u32x4*)((bf16_t*)(ws + WS_QIDX) + (size_t)t * 512 + lane * 8) = pk8(x); }
    { float x[8]; unpk8(T.ki, x); norm_rope_regs<8, true>(x, G.i, ci, si, 1.0f, lane); if (lane < 8) *(u32x4*)(ws + WS_KIDX + (size_t)(t >> 5) * 4096 + lane * 512 + (t & 31) * 16) = pk8(x); }
    if (lane < 8) ((float*)(ws + WS_WIDX))[(size_t)t * 8 + lane] = bf2f((unsigned short)T.wr) * 0.044194173824159216f;
}
__device__ __forceinline__ void p2_postproj(Frame& F, const Args& a) {
    const int gw = F.vcu * NWAVES + F.wave, NGW = F.G * NWAVES, lane = F.lane; unsigned char* ws = F.ws;
    if (gw >= NTOK) return;
    PPGain G; { const int hl = lane & 7; const float* qg = (const float*)a.in[11]; const float* kg = (const float*)a.in[12]; const float* ig = (const float*)a.in[13];
#pragma unroll
        for (int e = 0; e < 4; ++e) { G.q[e] = *(const f32x4*)(qg + hl * 16 + 4 * e); G.k[e] = *(const f32x4*)(kg + hl * 16 + 4 * e); }
#pragma unroll
        for (int e = 0; e < 2; ++e) G.i[e] = *(const f32x4*)(ig + hl * 8 + 4 * e); }
    PPTok cur; pp_load(cur, ws, gw, lane);
    for (int t = gw; t < NTOK; t += NGW) {
        PPTok nxt; const int tn = t + NGW < NTOK ? t + NGW : t; pp_load(nxt, ws, tn, lane);
        pp_finish(cur, G, ws, F.q8, t, lane);
        cur = nxt;
    }
}

constexpr int LRU_TC = 256, LRU_L = 64, LRU_NSC = SEQ / LRU_L, XA_STRIDE = 272, LRU_XA_BYTES = LRU_TC * XA_STRIDE, LRU_GT_OFF = 76800;
template <int PASS>
__device__ __forceinline__ void lru_unit(Frame& F, const Args& a, int b, int n, int j) {
    unsigned char* ws = F.ws; const int tid = F.tid, lane = F.lane, wave = F.wave;
    LAS unsigned char* xa = F.lds;
    LAS float* partA = (LAS float*)(F.lds + LRU_XA_BYTES); LAS float* partH = partA + 512; LAS float* carry = partH + 512;
    const int t0 = j * LRU_TC;
    float* lsA = (float*)(ws + WS_LSUM); float* lsH = lsA + (size_t)NB * LRU_NSC * DM;
    u32x4 gq[8];
    if (PASS == 1) { const int cg = tid & 15, rg = tid >> 4; const bf16_t* G = (const bf16_t*)(ws + WS_GATE) + (size_t)(b * SEQ + t0) * DM + 128 * n + 8 * cg;
#pragma unroll
        for (int r = 0; r < 8; ++r) gq[r] = __builtin_nontemporal_load((const u32x4*)(G + (size_t)(8 * rg + r) * DM)); }
    {
        const int cg = tid & 15, rg = tid >> 4; const int chb = 128 * n + 8 * cg;
        const bf16_t* X = (const bf16_t*)(ws + WS_LRUX) + (size_t)(b * SEQ) * DM + chb;
        const float* cw = (const float*)a.in[4]; const float* cbp = (const float*)a.in[5];
        float w[4][8], bias[8];
#pragma unroll
        for (int k = 0; k < 4; ++k) { const f32x4 u0 = *(const f32x4*)(cw + k * DM + chb), u1 = *(const f32x4*)(cw + k * DM + chb + 4);
            w[k][0] = u0.x; w[k][1] = u0.y; w[k][2] = u0.z; w[k][3] = u0.w; w[k][4] = u1.x; w[k][5] = u1.y; w[k][6] = u1.z; w[k][7] = u1.w; }
        { const f32x4 u0 = *(const f32x4*)(cbp + chb), u1 = *(const f32x4*)(cbp + chb + 4); bias[0] = u0.x; bias[1] = u0.y; bias[2] = u0.z; bias[3] = u0.w; bias[4] = u1.x; bias[5] = u1.y; bias[6] = u1.z; bias[7] = u1.w; }
        u32x4 xr[11];
#pragma unroll
        for (int i = 0; i < 11; ++i) { const int tt = t0 + 8 * rg - 3 + i; xr[i] = tt >= 0 ? *(const u32x4*)(X + (size_t)tt * DM) : (u32x4){0u, 0u, 0u, 0u}; }
#pragma unroll
        for (int r = 0; r < 8; ++r) { float o[8];
#pragma unroll
            for (int e = 0; e < 8; ++e) o[e] = bias[e];
#pragma unroll
            for (int k = 0; k < 4; ++k) { const u32x4 v = xr[r + k];
                o[0] += w[k][0] * bflo(v.x); o[1] += w[k][1] * bfhi(v.x); o[2] += w[k][2] * bflo(v.y); o[3] += w[k][3] * bfhi(v.y);
                o[4] += w[k][4] * bflo(v.z); o[5] += w[k][5] * bfhi(v.z); o[6] += w[k][6] * bflo(v.w); o[7] += w[k][7] * bfhi(v.w); }
            u32x4 pkd; pkd.x = pk2(o[0], o[1]); pkd.y = pk2(o[2], o[3]); pkd.z = pk2(o[4], o[5]); pkd.w = pk2(o[6], o[7]);
            *(LAS u32x4*)(xa + (8 * rg + r) * XA_STRIDE + cg * 16) = pkd; }
    }
    LAS unsigned char* gt = F.lds + LRU_GT_OFF;
    if (PASS == 1) {
        const int cg = tid & 15, rg = tid >> 4;
#pragma unroll
        for (int r = 0; r < 8; ++r) *(LAS u32x4*)(gt + (8 * rg + r) * XA_STRIDE + cg * 16) = gq[r];
    }
    if (PASS == 1) {
        const int chl = tid & 127, part = tid >> 7; const size_t cb = (size_t)b * LRU_NSC * DM + 128 * n + chl;
        float Ac = 1.f, Hc = 0.f;
        const int s1 = (part + 1) * j;
        for (int s = part * j; s < s1; s += 8) {
            float As[8], Hs[8];
#pragma unroll
            for (int q = 0; q < 8; ++q) { const int ss = s + q < s1 ? s + q : s1 - 1; As[q] = lsA[cb + (size_t)ss * DM]; Hs[q] = lsH[cb + (size_t)ss * DM]; }
#pragma unroll
            for (int q = 0; q < 8; ++q) if (s + q < s1) { Hc = As[q] * Hc + Hs[q]; Ac = As[q] * Ac; }
        }
        float A3[3], H3[3];
#pragma unroll
        for (int q = 0; q < 3; ++q) { A3[q] = lsA[cb + (size_t)(4 * j + q) * DM]; H3[q] = lsH[cb + (size_t)(4 * j + q) * DM]; }
        partA[part * 128 + chl] = Ac; partH[part * 128 + chl] = Hc;
        __syncthreads();
        if (part == 0) { float h = 0.f;
#pragma unroll
            for (int p = 0; p < 4; ++p) h = partA[p * 128 + chl] * h + partH[p * 128 + chl];
            carry[chl] = h;
#pragma unroll
            for (int q = 0; q < 3; ++q) { h = A3[q] * h + H3[q]; carry[(q + 1) * 128 + chl] = h; } }
    }
    __syncthreads();
    {
        const int sb = wave & 3, th = wave >> 2, hh = lane >> 5, d = 32 * sb + (lane & 31), ch = 128 * n + d;
        const bf16_t* WG = (const bf16_t*)(ws + WS_WG);
        bf16x8 Wr[8], Wi[8];
#pragma unroll
        for (int s = 0; s < 8; ++s) { Wr[s] = *(const bf16x8*)(WG + ((size_t)(n * 2 + 0) * 128 + d) * 128 + 16 * s + 8 * hh); Wi[s] = *(const bf16x8*)(WG + ((size_t)(n * 2 + 1) * 128 + d) * 128 + 16 * s + 8 * hh); }
        const float br = ((const float*)a.in[7])[ch], bi = ((const float*)a.in[9])[ch];
        const float sp8 = -8.0f * log1pf(expf(-((const float*)a.in[10])[ch]));
        float h = PASS == 1 ? carry[(2 * th + hh) * 128 + d] : 0.f, P = 1.f;
        const int rA = lane & 31, tlA = (2 * th + ((rA >> 2) & 1)) * 64 + (rA & 3) + 4 * (rA >> 3);
#pragma unroll 1
        for (int i = 0; i < 4; ++i) {
            f32x16 ar, ai;
#pragma unroll
            for (int e = 0; e < 16; ++e) { ar[e] = 0.f; ai[e] = 0.f; }
#pragma unroll
            for (int s = 0; s < 8; ++s) { const bf16x8 af = *(const LAS bf16x8*)(xa + (tlA + 16 * i) * XA_STRIDE + (16 * s + 8 * hh) * 2);
                ar = __builtin_amdgcn_mfma_f32_32x32x16_bf16(af, Wr[s], ar, 0, 0, 0); ai = __builtin_amdgcn_mfma_f32_32x32x16_bf16(af, Wi[s], ai, 0, 0, 0); }
            const int tl0 = (2 * th + hh) * 64 + 16 * i;
#pragma unroll
            for (int e = 0; e < 16; ++e) {
                const int tl = tl0 + e;
                const float xav = bf2f(*(const LAS bf16_t*)(xa + tl * XA_STRIDE + d * 2));
                const float r = sigmoidf_(ar[e] + br), ig = sigmoidf_(ai[e] + bi);
                const float la = sp8 * r, av = fast_exp(la), m2 = __builtin_fmaf(-av, av, 1.0f);
                const float u = __builtin_amdgcn_sqrtf(m2) * ig * xav;
                h = av * h + u;
                if (PASS == 0) P *= av;
                else { LAS bf16_t* gp = (LAS bf16_t*)(gt + tl * XA_STRIDE + d * 2); *gp = (bf16_t)f2bf(h * bf2f(*gp)); }
            }
        }
        if (PASS == 0) { const size_t o = ((size_t)b * LRU_NSC + 4 * j + 2 * th + hh) * DM + ch; lsA[o] = P; lsH[o] = h; }
    }
    __syncthreads();
    if (PASS == 1) {
        const int cg = tid & 15, rg = tid >> 4; bf16_t* Y = (bf16_t*)(ws + WS_XN) + (size_t)(b * SEQ + t0) * DM + 128 * n + 8 * cg;
#pragma unroll 2
        for (int r = 0; r < 8; ++r) *(u32x4*)(Y + (size_t)(8 * rg + r) * DM) = *(const LAS u32x4*)(gt + (8 * rg + r) * XA_STRIDE + cg * 16);
        __syncthreads();
    }
}
template <int PASS> __device__ __forceinline__ void lru_phase(Frame& F, const Args& a) {
    for (int u4 = F.vcu; u4 < 256; u4 += F.G)
        for (int i = 0; i < 4; ++i) { const int uid = u4 * 4 + i, j0 = (uid >> 3) & 31;
            lru_unit<PASS>(F, a, uid >> 8, uid & 7, (i & 1) ? 31 - j0 : j0); }
}

__device__ __forceinline__ void p7_router(Frame& F, const Args& a) {
    const int lane = F.lane; unsigned char* ws = F.ws;
    const bf16_t* xm = (const bf16_t*)(ws + WS_XMID); const float* wrt = (const float*)(ws + WS_WR); float* rstdE = (float*)(ws + WS_RSTDE);
    int* tokE = (int*)(ws + WS_TOKE); float* gateE = (float*)(ws + WS_GATEE); int* tinfo = (int*)(ws + WS_TINFO);
    unsigned* ecnt = F.ctl + CW_ECNT;
    LAS float* lg = (LAS float*)(F.lds + F.wave * 4096);
    const int ri = lane & 15, kk = lane >> 4;
    LAS unsigned* lc = (LAS unsigned*)(F.lds + NWAVES * 4096); LAS unsigned* gb = lc + 32;
    for (int mb = F.vcu * (NWAVES * 16); mb < NTOK; mb += F.G * (NWAVES * 16)) {
        const int m0 = mb + F.wave * 16;
        if (F.tid < 32) lc[F.tid] = 0u;
        const u32x4* ap = (const u32x4*)(xm + (size_t)(m0 + ri) * DM) + kk;
        const f32x4* bp0 = (const f32x4*)(wrt + (size_t)(ri) * DM) + 2 * kk;
        const f32x4* bp1 = (const f32x4*)(wrt + (size_t)(16 + ri) * DM) + 2 * kk;
        const f32x4* bp2 = (const f32x4*)(wrt + (size_t)(ri < 4 ? 32 + ri : 35) * DM) + 2 * kk;
        f32x4 acc0 = (f32x4){0.f, 0.f, 0.f, 0.f}, acc1 = acc0, acc2 = acc0; float ssq = 0.f;
        u32x4 aw[2]; f32x4 bw[2][6];
#define RT_LOAD(B_, S_) do { aw[B_] = ap[4 * (S_)]; bw[B_][0] = bp0[8 * (S_)]; bw[B_][1] = bp0[8 * (S_) + 1]; bw[B_][2] = bp1[8 * (S_)]; bw[B_][3] = bp1[8 * (S_) + 1]; bw[B_][4] = bp2[8 * (S_)]; bw[B_][5] = bp2[8 * (S_) + 1]; } while (0)
#define RT_MMA(B_) do { const u32x4 w_ = aw[B_]; \
            const f32x4 a0 = (f32x4){bflo(w_.x), bfhi(w_.x), bflo(w_.y), bfhi(w_.y)}, a1 = (f32x4){bflo(w_.z), bfhi(w_.z), bflo(w_.w), bfhi(w_.w)}; \
            ssq += ((a0.x * a0.x + a0.y * a0.y) + (a0.z * a0.z + a0.w * a0.w)) + ((a1.x * a1.x + a1.y * a1.y) + (a1.z * a1.z + a1.w * a1.w)); \
            _Pragma("unroll") for (int e = 0; e < 4; ++e) { acc0 = __builtin_amdgcn_mfma_f32_16x16x4f32(a0[e], bw[B_][0][e], acc0, 0, 0, 0); acc1 = __builtin_amdgcn_mfma_f32_16x16x4f32(a0[e], bw[B_][2][e], acc1, 0, 0, 0); acc2 = __builtin_amdgcn_mfma_f32_16x16x4f32(a0[e], bw[B_][4][e], acc2, 0, 0, 0); } \
            _Pragma("unroll") for (int e = 0; e < 4; ++e) { acc0 = __builtin_amdgcn_mfma_f32_16x16x4f32(a1[e], bw[B_][1][e], acc0, 0, 0, 0); acc1 = __builtin_amdgcn_mfma_f32_16x16x4f32(a1[e], bw[B_][3][e], acc1, 0, 0, 0); acc2 = __builtin_amdgcn_mfma_f32_16x16x4f32(a1[e], bw[B_][5][e], acc2, 0, 0, 0); } } while (0)
        RT_LOAD(0, 0);
        for (int s = 0; s < 32; s += 2) { RT_LOAD(1, s + 1); RT_MMA(0); if (s + 2 < 32) RT_LOAD(0, s + 2); RT_MMA(1); }
#undef RT_LOAD
#undef RT_MMA
        ssq += __shfl_xor(ssq, 16); ssq += __shfl_xor(ssq, 32);
        const float rstd = 1.0f / sqrtf(ssq * (1.f / DM) + NORM_EPS);
#pragma unroll
        for (int e = 0; e < 4; ++e) { lg[(4 * kk + e) * 48 + ri] = acc0[e]; lg[(4 * kk + e) * 48 + 16 + ri] = acc1[e]; lg[(4 * kk + e) * 48 + 32 + ri] = acc2[e]; }
        if (kk == 0) lg[768 + ri] = rstd;
        asm volatile("s_waitcnt lgkmcnt(0)" ::: "memory");
        int e1 = 0, e2 = 0; float g1 = 0.f, g2 = 0.f, rs = 0.f;
        if (lane < 16) {
            rs = lg[768 + lane]; const float* bg = (const float*)a.in[19]; const float* be = (const float*)a.in[21];
            float gl[4]; int gs = 0; float gmax = -__builtin_inff();
#pragma unroll
            for (int c = 0; c < 4; ++c) { gl[c] = lg[lane * 48 + c] * rs + bg[c]; if (gl[c] > gmax) { gmax = gl[c]; gs = c; } }
            float gsum = 0.f;
#pragma unroll
            for (int c = 0; c < 4; ++c) gsum += fast_exp(gl[c] - gmax);
            const float pgrp = 1.0f / gsum;
            float m1 = -__builtin_inff(), mx2 = -__builtin_inff(); int j1 = 0, j2 = 0;
            const f32x4 be0 = *(const f32x4*)(be + 8 * gs), be1 = *(const f32x4*)(be + 8 * gs + 4); const float bev[8] = {be0.x, be0.y, be0.z, be0.w, be1.x, be1.y, be1.z, be1.w};
#pragma unroll
            for (int c = 0; c < 8; ++c) { const float v = lg[lane * 48 + 4 + 8 * gs + c] * rs + bev[c];
                if (v > m1) { mx2 = m1; j2 = j1; m1 = v; j1 = c; } else if (v > mx2) { mx2 = v; j2 = c; } }
            const float ex = fast_exp(mx2 - m1); g1 = pgrp / (1.0f + ex); g2 = pgrp - g1;
            e1 = 8 * gs + j1; e2 = 8 * gs + j2;
        }
        __syncthreads();
        unsigned l1 = 0u, l2 = 0u;
        if (lane < 16) { l1 = __hip_atomic_fetch_add(lc + e1, 1u, __ATOMIC_RELAXED, __HIP_MEMORY_SCOPE_WORKGROUP); l2 = __hip_atomic_fetch_add(lc + e2, 1u, __ATOMIC_RELAXED, __HIP_MEMORY_SCOPE_WORKGROUP); }
        __syncthreads();
        if (F.tid < 32) { const unsigned n = lc[F.tid]; gb[F.tid] = n ? __hip_atomic_fetch_add(ecnt + 64 * F.tid, n, RLX_AGENT) : 0u; }
        __syncthreads();
        if (lane < 16) { const int tok = m0 + lane, p1 = (int)(gb[e1] + l1), p2 = (int)(gb[e2] + l2);
            tokE[(size_t)e1 * NTOK + p1] = tok; gateE[(size_t)e1 * NTOK + p1] = g1; tokE[(size_t)e2 * NTOK + p2] = tok; gateE[(size_t)e2 * NTOK + p2] = g2;
            rstdE[(size_t)e1 * NTOK + p1] = rs; rstdE[(size_t)e2 * NTOK + p2] = rs;
            *(int4*)(tinfo + (size_t)tok * 4) = make_int4(e1, p1, e2, p2);
        }
        asm volatile("s_waitcnt lgkmcnt(0)" ::: "memory");
    }
}

constexpr int MOE_LDS_OFF = LDSCTL_OFF + 1024;
__device__ __forceinline__ void moe_sched_setup(Frame& F) {
    LAS int* sc = (LAS int*)(F.lds + MOE_LDS_OFF);
    if (F.tid < 32) sc[F.tid] = (int)__hip_atomic_load(F.ctl + CW_ECNT + 64 * F.tid, RLX_AGENT);
    __syncthreads();
    if (F.tid == 0) { int s = 0; for (int e = 0; e < 32; ++e) { sc[32 + e] = s; s += (sc[e] + 255) >> 8; } sc[64] = s; }
    __syncthreads();
}
template <bool GATHER> struct GroupOrder {
    LAS const int* sc; int G, c; const char* W; size_t estride, tstepB; const int* tokE;
    __device__ __forceinline__ bool next(int i, Unit& u) const {
        const int L = i * G + c, TM = sc[64]; if (L >= 4 * TM) return false;
        const int rt = L >> 2, pn = L & 3; int e = 0;
        for (int q = 1; q < 32; ++q) e = sc[32 + q] <= rt ? q : e;
        u.pm = rt; u.pn = pn; u.aux = e * 128 + (rt - sc[32 + e]); u.B = W + (size_t)e * estride + (size_t)pn * tstepB; return true;
    }
    __device__ __forceinline__ int arow(const Unit& u, int r) const {
        if (!GATHER) return u.pm * 256 + r;
        const int e = u.aux >> 7, idx = (u.aux & 127) * 256 + r;
        return idx < sc[e] ? tokE[(size_t)e * NTOK + idx] : 0;
    }
};
__device__ __forceinline__ void p10_combine(Frame& F, const Args& a) {
    const int gw = F.vcu * NWAVES + F.wave, NGW = F.G * NWAVES, lane = F.lane; unsigned char* ws = F.ws;
    LAS const int* sc = (LAS const int*)(F.lds + MOE_LDS_OFF);
    const int* tinfo = (const int*)(ws + WS_TINFO); const bf16_t* y = (const bf16_t*)(ws + WS_Y); float* out = a.out;
    if (gw >= NTOK) return;
    int4 ti = *(const int4*)(tinfo + (size_t)gw * 4);
    for (int t = gw; t < NTOK; t += NGW) {
        const size_t s1 = (size_t)sc[32 + ti.x] * 256 + ti.y, s2 = (size_t)sc[32 + ti.z] * 256 + ti.w;
        GAS f32x4* xr = (GAS f32x4*)(out + (size_t)t * DM) + lane; const GAS u32x2* xm = (const GAS u32x2*)((const bf16_t*)(ws + WS_XMID) + (size_t)t * DM) + lane;
        const GAS u32x2* y1 = (const GAS u32x2*)(y + s1 * DM) + lane; const GAS u32x2* y2 = (const GAS u32x2*)(y + s2 * DM) + lane;
        u32x2 xw[4], p[4], q[4];
#pragma unroll
        for (int j = 0; j < 4; ++j) { xw[j] = __builtin_nontemporal_load(xm + 64 * j); p[j] = __builtin_nontemporal_load(y1 + 64 * j); q[j] = __builtin_nontemporal_load(y2 + 64 * j); }
        const int tn = t + NGW < NTOK ? t + NGW : t;
        ti = *(const int4*)(tinfo + (size_t)tn * 4);
        asm volatile("" ::: "memory");
#pragma unroll
        for (int j = 0; j < 4; ++j) { f32x4 v = (f32x4){bflo(xw[j].x), bfhi(xw[j].x), bflo(xw[j].y), bfhi(xw[j].y)};
            v.x += bflo(p[j].x) + bflo(q[j].x); v.y += bfhi(p[j].x) + bfhi(q[j].x); v.z += bflo(p[j].y) + bflo(q[j].y); v.w += bfhi(p[j].y) + bfhi(q[j].y);
            __builtin_nontemporal_store(v, xr + 64 * j); }
    }
}


constexpr int CAP = 576, S1_KS = 56;
__device__ __forceinline__ unsigned mbcnt64(unsigned long long m) { return __builtin_amdgcn_mbcnt_hi((unsigned)(m >> 32), __builtin_amdgcn_mbcnt_lo((unsigned)m, 0u)); }
__device__ __forceinline__ unsigned wave_or_u32(unsigned v) {
    v |= (unsigned)__builtin_amdgcn_update_dpp(0, (int)v, 0x121, 0xF, 0xF, false); v |= (unsigned)__builtin_amdgcn_update_dpp(0, (int)v, 0x122, 0xF, 0xF, false);
    v |= (unsigned)__builtin_amdgcn_update_dpp(0, (int)v, 0x124, 0xF, 0xF, false); v |= (unsigned)__builtin_amdgcn_update_dpp(0, (int)v, 0x128, 0xF, 0xF, false);
    return (unsigned)__builtin_amdgcn_readlane((int)v, 0) | (unsigned)__builtin_amdgcn_readlane((int)v, 16) | (unsigned)__builtin_amdgcn_readlane((int)v, 32) | (unsigned)__builtin_amdgcn_readlane((int)v, 48);
}
template <bool REWRITE>
__device__ __forceinline__ unsigned select_rank(LAS unsigned* qb, int n, int lane, int& newcnt, const int target, const int slack) {
    unsigned e[9]; unsigned orl = 0u, norl = 0u;
#pragma unroll
    for (int i = 0; i < 9; ++i) { const int idx = lane + 64 * i; const bool ok = idx < n; e[i] = ok ? qb[idx] : 0u; orl |= e[i]; norl |= ok ? ~e[i] : 0u; }
    const unsigned orv = wave_or_u32(orl), andv = ~wave_or_u32(norl), diff = orv ^ andv;
    const int hb = 31 - __builtin_clz(diff | 1u);
    unsigned T = andv & ~((2u << hb) - 1u); int cT = n;
    for (int bit = hb; bit >= 0; --bit) {
        const unsigned cand = T | (1u << bit); int c = 0;
#pragma unroll
        for (int i = 0; i < 9; ++i) c += __builtin_popcountll(__ballot(e[i] >= cand));
        if (c >= target) { T = cand; cT = c; if (c <= target + slack) break; }
    }
    if (REWRITE) { int base = 0;
#pragma unroll
        for (int i = 0; i < 9; ++i) { const bool keep = e[i] >= T; const unsigned long long m = __ballot(keep); if (keep) qb[base + (int)mbcnt64(m)] = e[i]; base += __builtin_popcountll(m); }
        newcnt = base; }
    else newcnt = cT;
    return T;
}
template <bool FINAL>
__device__ __forceinline__ unsigned select256(LAS unsigned* qb, int n, int lane, int& newcnt) { return select_rank<true>(qb, n, lane, newcnt, 256, FINAL ? 0 : 64); }
__device__ __forceinline__ void dsa_chunk(Frame& F, const Args& a, int b, int c) {
    unsigned char* ws = F.ws; const int lane = F.lane, wave = F.wave, hh = lane >> 5;
    LAS unsigned* wbuf = (LAS unsigned*)(F.lds + wave * (8 * CAP * 4));
    const int qbase = b * SEQ + c * 64 + 8 * wave;
    int nsel[8];
    {
        const bf16_t* QI = (const bf16_t*)(ws + WS_QIDX); const float* WI = (const float*)(ws + WS_WIDX); const bf16_t* KI = (const bf16_t*)(ws + WS_KIDX) + (size_t)b * SEQ * 64;
        bf16x8 Aq[2][4]; float wv[2][16];
        { const int r = lane & 31, j_ = r & 3, hb = (r >> 2) & 1, g = r >> 3, h = j_ + 4 * (g & 1), tq = hb + 2 * (g >> 1);
#pragma unroll
          for (int rt = 0; rt < 2; ++rt)
#pragma unroll
              for (int s = 0; s < 4; ++s) Aq[rt][s] = *(const bf16x8*)(QI + (size_t)(qbase + 4 * rt + tq) * 512 + h * 64 + 16 * s + 8 * hh);
#pragma unroll
          for (int rt = 0; rt < 2; ++rt)
#pragma unroll
              for (int gq = 0; gq < 2; ++gq) { const float* wp = WI + (size_t)(qbase + 4 * rt + hh + 2 * gq) * 8; const f32x4 w0 = *(const f32x4*)wp, w1 = *(const f32x4*)(wp + 4);
                  wv[rt][8 * gq + 0] = w0.x; wv[rt][8 * gq + 1] = w0.y; wv[rt][8 * gq + 2] = w0.z; wv[rt][8 * gq + 3] = w0.w; wv[rt][8 * gq + 4] = w1.x; wv[rt][8 * gq + 5] = w1.y; wv[rt][8 * gq + 6] = w1.z; wv[rt][8 * gq + 7] = w1.w; } }
        unsigned thr[8] = {0u, 0u, 0u, 0u, 0u, 0u, 0u, 0u}; int cntv[8] = {0, 0, 0, 0, 0, 0, 0, 0};
        const int nkt = (c + 1) * 2;
        const char* KIb = (const char*)KI;
        auto scan = [&](const int st, const int njt, const int keep, const int skipn) {
            auto tix = [&](int o) { return skipn ? (o < 7 * skipn ? o + o / 7 + 1 : o + skipn) : o * st; };
            bf16x8 Bq[2][4];
#pragma unroll
            for (int i = 0; i < 2; ++i) { const int kti = tix(i < njt ? i : njt - 1);
#pragma unroll
                for (int s = 0; s < 4; ++s) Bq[i][s] = *(const bf16x8*)(KIb + (size_t)kti * 4096 + (2 * s + hh) * 512 + (lane & 31) * 16); }
            int j = 0;
#pragma unroll 1
            while (j < njt) {
                int mxc = 0;
#pragma unroll
                for (int k = 0; k < 8; ++k) mxc = cntv[k] > mxc ? cntv[k] : mxc;
                const int run = ((CAP - mxc) >> 5) & ~1;
                if (run == 0) {
#pragma unroll
                    for (int k = 0; k < 4; ++k)
#pragma unroll
                        for (int hq = 0; hq < 2; ++hq) { const int n = cntv[2 * k + hq];
                            if (n > CAP - 64) { int nc; const unsigned T = select_rank<true>(wbuf + (2 * k + hq) * CAP, n, lane, nc, keep, 128);
                                thr[2 * k + hq] = T - 1u; cntv[2 * k + hq] = nc; } }
                    continue;
                }
                const int jend = j + run < njt ? j + run : njt;
#pragma unroll 1
                for (; j < jend; j += 2) {
                    unsigned keys[2][4];
#pragma unroll
                    for (int i = 0; i < 2; ++i) {
                        const int jj = j + i;
                        if (jj < jend) {
                            const int kti = tix(jj);
                            const unsigned kinv = 8191u - (unsigned)(32 * kti + (lane & 31));
                            f32x16 accs[2];
#pragma unroll
                            for (int rt = 0; rt < 2; ++rt) {
#pragma unroll
                                for (int e = 0; e < 16; ++e) accs[rt][e] = 0.f;
#pragma unroll
                                for (int s = 0; s < 4; ++s) accs[rt] = __builtin_amdgcn_mfma_f32_32x32x16_bf16(Aq[rt][s], Bq[i][s], accs[rt], 0, 0, 0); }
                            asm volatile("s_nop 15" : "+v"(accs[0]), "+v"(accs[1]));
                            { const int ktn = tix(jj + 2 < njt ? jj + 2 : njt - 1);
#pragma unroll
                              for (int s = 0; s < 4; ++s) Bq[i][s] = *(const bf16x8*)(KIb + (size_t)ktn * 4096 + (2 * s + hh) * 512 + (lane & 31) * 16); }
#pragma unroll
                            for (int rt = 0; rt < 2; ++rt) {
                                const f32x16 acc = accs[rt];
#pragma unroll
                                for (int gq = 0; gq < 2; ++gq) {
                                    float s0 = 0.f, s1 = 0.f;
#pragma unroll
                                    for (int h = 0; h < 8; h += 2) { float m0, m1; asm("v_max_f32_e32 %0, 0, %1" : "=v"(m0) : "v"(acc[8 * gq + h])); asm("v_max_f32_e32 %0, 0, %1" : "=v"(m1) : "v"(acc[8 * gq + h + 1]));
                                        s0 = __builtin_fmaf(wv[rt][8 * gq + h], m0, s0); s1 = __builtin_fmaf(wv[rt][8 * gq + h + 1], m1, s1); }
                                    const float sc = s0 + s1;
                                    const unsigned u = __builtin_bit_cast(unsigned, sc); const unsigned ord = u ^ ((unsigned)((int)u >> 31) | 0x80000000u);
                                    keys[i][2 * rt + gq] = (ord & 0xFFFFE000u) | kinv;
                                }
                            }
                        } else {
#pragma unroll
                            for (int k = 0; k < 4; ++k) keys[i][k] = 0u;
                        }
                        asm volatile("" : "+v"(keys[i][0]), "+v"(keys[i][1]), "+v"(keys[i][2]), "+v"(keys[i][3]));
                    }
#pragma unroll
                    for (int k = 0; k < 4; ++k) {
                        const auto r = __builtin_amdgcn_permlane32_swap(keys[0][k], keys[1][k], false, false);
#pragma unroll
                        for (int hq = 0; hq < 2; ++hq) { const unsigned key = r[hq];
                            const bool pass = key > thr[2 * k + hq];
                            const unsigned long long m = __ballot(pass);
                            if (pass) wbuf[(2 * k + hq) * CAP + cntv[2 * k + hq] + (int)mbcnt64(m)] = key;
                            cntv[2 * k + hq] += __builtin_popcountll(m); }
                    }
                }
                j = jend;
            }
        };
        bool sampled = false;
        if (nkt >= 32) {
            sampled = true;
            scan(8, nkt >> 3, S1_KS, 0);
#pragma unroll
            for (int k = 0; k < 4; ++k)
#pragma unroll
                for (int hq = 0; hq < 2; ++hq) { const int n = cntv[2 * k + hq]; unsigned T = 1u;
                    int nc = n;
                    if (n > S1_KS) T = select_rank<true>(wbuf + (2 * k + hq) * CAP, n, lane, nc, S1_KS, 8);
                    thr[2 * k + hq] = T - 1u; cntv[2 * k + hq] = nc; }
        }
        for (;;) {
            { const int sk = sampled ? nkt >> 3 : 0; scan(1, nkt - sk, 256, sk); }
            bool shortfall = false;
#pragma unroll
            for (int k = 0; k < 4; ++k)
#pragma unroll
                for (int hq = 0; hq < 2; ++hq) { int n = cntv[2 * k + hq];
                    if (n > 256) { int nc; (void)select256<true>(wbuf + (2 * k + hq) * CAP, n, lane, nc); n = nc; }
                    else if (n < 256 && sampled) shortfall = true;
                    nsel[2 * k + hq] = n; cntv[2 * k + hq] = n; }
            if (!shortfall) break;
            sampled = false;
#pragma unroll
            for (int k = 0; k < 8; ++k) { if (cntv[k] < 256) { thr[k] = 0u; cntv[k] = 0; } else thr[k] = 0xFFFFFFFFu; }
        }
    }
    unsigned short* LIST = (unsigned short*)(ws + WS_LIST);
#pragma unroll
    for (int qi = 0; qi < 8; ++qi) { const int ns = nsel[qi]; const u32x4 kq = *(const LAS u32x4*)(wbuf + qi * CAP + 4 * lane);
        const unsigned i0 = 4 * lane + 0 < ns ? 8191u - (kq.x & 0x1FFFu) : 0u, i1 = 4 * lane + 1 < ns ? 8191u - (kq.y & 0x1FFFu) : 0u, i2 = 4 * lane + 2 < ns ? 8191u - (kq.z & 0x1FFFu) : 0u, i3 = 4 * lane + 3 < ns ? 8191u - (kq.w & 0x1FFFu) : 0u;
        u32x2 o; o.x = i0 | (i1 << 16); o.y = i2 | (i3 << 16);
        *(u32x2*)(LIST + (size_t)(qbase + qi) * 256 + 4 * lane) = o; }
}
__device__ __forceinline__ void dsa_phase(Frame& F, const Args& a) {
    for (int p = F.vcu; p < 256; p += F.G) { const int b = p >> 6, c0 = p & 63; dsa_chunk(F, a, b, c0); dsa_chunk(F, a, b, 127 - c0); }
}


typedef short v4i16_t __attribute__((ext_vector_type(4)));
constexpr int S2_WAVE_LDS = 17408, S2_LIST_OFF = 16384;
#define S2_WAIT(n) asm volatile("s_waitcnt vmcnt(" #n ")" ::: "memory")
__device__ __forceinline__ void dsa2_item(Frame& F, int b, int t, int j) {
    unsigned char* ws = F.ws; const int lane = F.lane, hd = lane & 15, g4 = lane >> 4;
    LAS unsigned char* wl = F.lds + F.wave * S2_WAVE_LDS;
    LAS unsigned short* lst = (LAS unsigned short*)(wl + S2_LIST_OFF);
    const size_t tq = (size_t)b * SEQ + t;
    const int nadm = ((t >> 6) + 1) * 64, ns = nadm < 256 ? nadm : 256;
    const bf16_t* Q = (const bf16_t*)(ws + WS_Q);
    const char* Kb = (const char*)(ws + WS_K8) + (size_t)b * SEQ * 256 + j * 128; const char* Vb = (const char*)(ws + WS_V8) + (size_t)b * SEQ * 256 + j * 128;
    { const u32x2 lv = *(const u32x2*)((const unsigned short*)(ws + WS_LIST) + tq * 256 + 4 * lane);
      long qf[4];
#pragma unroll
      for (int s = 0; s < 4; ++s) qf[s] = *(const long*)(F.q8 + tq * DM + (4 * j + (hd & 3)) * 128 + 32 * s + 8 * g4);
      S2_WAIT(0);
      *(LAS u32x2*)(lst + 4 * lane) = lv;
      asm volatile("s_waitcnt lgkmcnt(0)" ::: "memory");
      long Bq[4];
#pragma unroll
      for (int s = 0; s < 4; ++s) Bq[s] = hd < 4 ? qf[s] : 0l;
      const int dr8 = lane >> 3, dc8 = lane & 7;
#define S2_DMAK(g_) do { _Pragma("unroll") for (int _m = 0; _m < 2; ++_m) { const int _row = 8 * _m + dr8; const unsigned _kx = lst[16 * (g_) + _row]; \
          __builtin_amdgcn_global_load_lds((const unsigned*)(Kb + (size_t)_kx * 256 + ((dc8 ^ (_row & 7)) << 4)), (LAS unsigned*)(wl + ((g_) & 7) * 2048 + _m * 1024), 16, 0, 0); } } while (0)
      S2_DMAK(0); S2_DMAK(1); S2_DMAK(2); S2_DMAK(3); S2_DMAK(4); S2_DMAK(5);
      f32x4 sreg[16];
#pragma unroll
      for (int g = 0; g < 16; ++g) {
          if (g + 6 < 16) { S2_DMAK(g + 6); S2_WAIT(12); } else if (g == 10) { S2_WAIT(10); } else if (g == 11) { S2_WAIT(8); } else if (g == 12) { S2_WAIT(6); } else if (g == 13) { S2_WAIT(4); } else if (g == 14) { S2_WAIT(2); } else { S2_WAIT(0); }
          LAS const unsigned char* sl = wl + (g & 7) * 2048 + hd * 128 + (g4 & 1) * 8;
          f32x4 acc = (f32x4){0.f, 0.f, 0.f, 0.f};
#pragma unroll
          for (int s = 0; s < 4; ++s) { const long af = *(const LAS long*)(sl + (((2 * s + (g4 >> 1)) ^ (hd & 7)) << 4)); acc = __builtin_amdgcn_mfma_f32_16x16x32_fp8_fp8(af, Bq[s], acc, 0, 0, 0); }
          sreg[g] = acc;
      }
      if (ns < 256) {
#pragma unroll
          for (int g = 0; g < 16; ++g) if (!(16 * g < ns)) sreg[g] = (f32x4){-1e30f, -1e30f, -1e30f, -1e30f}; }
      asm volatile("s_waitcnt lgkmcnt(0)" ::: "memory");
#define S2_DMAV(g_) do { _Pragma("unroll") for (int _m = 0; _m < 2; ++_m) { const int _row = 8 * _m + dr8; const unsigned _kx = lst[16 * (g_) + _row]; \
          __builtin_amdgcn_global_load_lds((const unsigned*)(Vb + (size_t)_kx * 256 + ((dc8 ^ (_row & 7)) << 4)), (LAS unsigned*)(wl + ((g_) & 7) * 2048 + _m * 1024), 16, 0, 0); } } while (0)
      S2_DMAV(0); S2_DMAV(1); S2_DMAV(2); S2_DMAV(3); S2_DMAV(4); S2_DMAV(5);
      float mx = -1e30f;
#pragma unroll
      for (int g = 0; g < 16; ++g) mx = fmaxf(mx, fmaxf(fmaxf(sreg[g][0], sreg[g][1]), fmaxf(sreg[g][2], sreg[g][3])));
      mx = fmaxf(mx, __shfl_xor(mx, 16)); mx = fmaxf(mx, __shfl_xor(mx, 32));
      const float mxb = 8.0f - mx * QSCALE;
      float lsp[4] = {0.f, 0.f, 0.f, 0.f};
#pragma unroll
      for (int g = 0; g < 16; ++g)
#pragma unroll
          for (int e = 0; e < 4; ++e) { const float p = __builtin_amdgcn_exp2f(__builtin_fmaf(sreg[g][e], QSCALE, mxb)); sreg[g][e] = p; lsp[e] += p; }
      float ls = (lsp[0] + lsp[1]) + (lsp[2] + lsp[3]);
      ls += __shfl_xor(ls, 16); ls += __shfl_xor(ls, 32);
      f32x4 o[8];
#pragma unroll
      for (int ct = 0; ct < 8; ++ct) o[ct] = (f32x4){0.f, 0.f, 0.f, 0.f};
      const int tq_ = hd >> 1, tp = hd & 1, trow = 4 * g4 + (tq_ & 3), tsel = tq_ >> 2;
      typedef int v2i32_t __attribute__((ext_vector_type(2)));
      unsigned vx[8];
#pragma unroll
      for (int ct = 0; ct < 8; ++ct) vx[ct] = (unsigned)((ct ^ (trow & 7)) << 4);
#pragma unroll
      for (int ks = 0; ks < 8; ++ks) {
          if (ks + 3 < 8) { S2_DMAV(2 * ks + 6); S2_DMAV(2 * ks + 7); }
          if (ks <= 4) { S2_WAIT(12); } else if (ks == 5) { S2_WAIT(8); } else if (ks == 6) { S2_WAIT(4); } else { S2_WAIT(0); }
          const unsigned plo = fp8x4(sreg[2 * ks][0], sreg[2 * ks][1], sreg[2 * ks][2], sreg[2 * ks][3]), phi = fp8x4(sreg[2 * ks + 1][0], sreg[2 * ks + 1][1], sreg[2 * ks + 1][2], sreg[2 * ks + 1][3]);
          const long af = (long)(((unsigned long long)phi << 32) | plo);
          LAS const unsigned char* sV = wl + (tsel ? ((2 * ks + 1) & 7) : ((2 * ks) & 7)) * 2048 + trow * 128 + tp * 8;
          const unsigned va = (unsigned)(size_t)sV;
          v2i32_t bv[8];
          asm volatile("ds_read_b64_tr_b8 %0, %8\n\tds_read_b64_tr_b8 %1, %9\n\tds_read_b64_tr_b8 %2, %10\n\tds_read_b64_tr_b8 %3, %11\n\t"
                       "ds_read_b64_tr_b8 %4, %12\n\tds_read_b64_tr_b8 %5, %13\n\tds_read_b64_tr_b8 %6, %14\n\tds_read_b64_tr_b8 %7, %15\n\ts_waitcnt lgkmcnt(0)"
                       : "=&v"(bv[0]), "=&v"(bv[1]), "=&v"(bv[2]), "=&v"(bv[3]), "=&v"(bv[4]), "=&v"(bv[5]), "=&v"(bv[6]), "=&v"(bv[7])
                       : "v"(va + vx[0]), "v"(va + vx[1]), "v"(va + vx[2]), "v"(va + vx[3]), "v"(va + vx[4]), "v"(va + vx[5]), "v"(va + vx[6]), "v"(va + vx[7]) : "memory");
#pragma unroll
          for (int ct = 0; ct < 8; ++ct) o[ct] = __builtin_amdgcn_mfma_f32_16x16x32_fp8_fp8(af, __builtin_bit_cast(long, bv[ct]), o[ct], 0, 0, 0);
      }
#undef S2_DMAV
#undef S2_DMAK
      float li[4];
#pragma unroll
      for (int e = 0; e < 4; ++e) li[e] = 1.0f / __shfl(ls, e);
      if (g4 == 0) { bf16_t* yb = (bf16_t*)(ws + WS_Q) + tq * DM + (4 * j) * 128 + hd;
#pragma unroll
          for (int e = 0; e < 4; ++e)
#pragma unroll
              for (int ct = 0; ct < 8; ++ct) yb[e * 128 + 16 * ct] = (bf16_t)f2bf(o[ct][e] * li[e]); }
    }
}
__device__ __forceinline__ void dsa2_phase(Frame& F, const Args& a) {
    for (int p = F.vcu; p < 256; p += F.G) { const int x = p >> 5, b = x >> 1, j = x & 1, wl_ = (p & 31) * NWAVES + F.wave;
        for (int i = 0; i < 32; ++i) dsa2_item(F, b, wl_ + 256 * i, j); }
}

__global__ void __launch_bounds__(NWAVES * 64, 2) fwd_kernel(Args args) {
    extern __shared__ __attribute__((aligned(16))) unsigned char lds[];
    Frame F;
    F.lds = (LAS unsigned char*)lds; F.MISC = (volatile LAS unsigned*)(F.lds + MISC_OFF);
    F.tid = threadIdx.x; F.lane = F.tid & 63; F.wave = __builtin_amdgcn_readfirstlane(F.tid >> 6);
    F.G = gridDim.x; { const int bx = blockIdx.x; F.vcu = (F.G % 8 == 0) ? (bx % 8) * (F.G / 8) + bx / 8 : bx; }
    F.ws = args.ws; F.ctl = (unsigned*)(args.ws + WS_CTL); F.q8 = (unsigned char*)args.out + (size_t)64 * MiB;
    for (int u = F.tid; u < (LDS_BYTES - LDSCTL_OFF) / 4; u += NWAVES * 64) ((LAS unsigned*)(F.lds + LDSCTL_OFF))[u] = 0u;
    __syncthreads();
    XcdBarrier bar; bar.bar = F.ctl + CW_BAR; bar.x = 0; bar.st = nullptr;
    if (MK_N_LAUNCHES == 1) bar = xcd_barrier_post(F.ctl + CW_BAR, F.MISC + 8);
#define GRID_BAR() do { if (MK_N_LAUNCHES == 1) xcd_barrier(bar); } while (0)
    const int lo = args.ph_lo, hi = args.ph_hi;
#define IN(k) (lo <= (k) && (k) < hi)
#define BOTH(k) (IN(k) && IN((k) + 1))
    unsigned char* ws = args.ws;
    if (IN(0)) { p0_prologue(F, args); if (BOTH(0)) GRID_BAR(); }
    if (IN(1)) {
        pg8::Gemm g{(const char*)(ws + WS_XN), DM * 2, DM}; pg8::DenseOrder S; S.init(NTOK, NP, DM, F.G, (int)blockIdx.x, ws + WS_WIN);
        EpiProj E{ws, (unsigned char*)args.out};
        pg8::gemm_phase(F.lds, g, S, E);
        { LAS float* scr = (LAS float*)(F.lds + F.wave * 16384); const int lane = F.lane;
          tail_items(F, (int)blockIdx.x, S.nwg % F.G, I_W13 - DEF_W13, I_W13, [&](int r) { p0_item_w13(args, ws, r, scr, lane); }); }
        if (BOTH(1)) GRID_BAR();
    }
    if (IN(2)) { p2_postproj(F, args); __syncthreads(); lru_phase<0>(F, args); if (BOTH(2)) GRID_BAR(); }
    if (IN(3)) { lru_phase<1>(F, args);
        __syncthreads(); dsa_phase(F, args);
        if (BOTH(3)) GRID_BAR(); }
    auto g2a = [&]() {
        pg8::Gemm g{(const char*)(ws + WS_XN), DM * 2, DM}; pg8::DenseOrder S; S.init(NTOK, DM, DM, F.G, (int)blockIdx.x, ws + WS_WA);
        EpiMerge<false> E{(const unsigned char*)args.out, 0, nullptr, (bf16_t*)(ws + WS_LRUX)};
        pg8::gemm_phase(F.lds, g, S, E); };
    if (BOTH(4) && ((blockIdx.x >> 3) & 1)) { g2a(); __syncthreads(); dsa2_phase(F, args); __syncthreads(); if (BOTH(5)) GRID_BAR(); }
    else {
        if (IN(4)) { dsa2_phase(F, args); __syncthreads(); }
        if (IN(5)) { g2a(); if (BOTH(5)) GRID_BAR(); }
    }
    if (IN(6)) {
        pg8::Gemm g{(const char*)(ws + WS_Q), DM * 2, DM}; pg8::DenseOrder S; S.init(NTOK, DM, DM, F.G, (int)blockIdx.x, ws + WS_WB);
        EpiMerge<true> E{(const unsigned char*)args.out, 1024, (const bf16_t*)(ws + WS_LRUX), (bf16_t*)(ws + WS_GATE)};
        pg8::gemm_phase(F.lds, g, S, E);
        if (BOTH(6)) GRID_BAR();
    }
    if (IN(7)) {
        pg8::Gemm g{(const char*)(ws + WS_GATE), DM * 2, DM}; pg8::DenseOrder S; S.init(NTOK, DM, DM, F.G, (int)blockIdx.x, ws + WS_WO);
        EpiResid E{(const float*)args.in[0], (bf16_t*)(ws + WS_XMID)};
        pg8::gemm_phase(F.lds, g, S, E);
        if (BOTH(7)) GRID_BAR();
    }
    if (IN(8)) {
        auto w13_share = [&]() { LAS float* scr = (LAS float*)(F.lds + 40960 + F.wave * 8704); const int lane = F.lane;
            for (int r = F.vcu * NWAVES + F.wave; r < I_W13 - DEF_W13; r += F.G * NWAVES) p0_item_w13(args, ws, r, scr, lane); };
        if (F.vcu & 1) { w13_share(); __syncthreads(); p7_router(F, args); } else { p7_router(F, args); w13_share(); }
        if (BOTH(8)) GRID_BAR(); }
    if (IN(9)) {
        moe_sched_setup(F);
        pg8::Gemm g{(const char*)(ws + WS_XMID), DM * 2, DM};
        GroupOrder<true> S{(LAS const int*)(F.lds + MOE_LDS_OFF), F.G, F.vcu, (const char*)(ws + WS_W13), (size_t)1024 * DM * 2, (size_t)256 * DM * 2, (const int*)(ws + WS_TOKE)};
        EpiGlu E{(bf16_t*)(ws + WS_ACT), (const float*)(ws + WS_RSTDE)};
        pg8::gemm_phase(F.lds, g, S, E);
        { LAS float* scr = (LAS float*)(F.lds + F.wave * 16384); const int lane = F.lane;
          tail_items(F, F.vcu, (4 * S.sc[64]) % F.G, 0, I_W2, [&](int r) { p0_item_w2(args, ws, r, scr, lane); }); }
        if (BOTH(9)) GRID_BAR();
    }
    if (IN(10)) {
        moe_sched_setup(F);
        pg8::Gemm g{(const char*)(ws + WS_ACT), EFF * 2, EFF};
        GroupOrder<false> S{(LAS const int*)(F.lds + MOE_LDS_OFF), F.G, F.vcu, (const char*)(ws + WS_W2), (size_t)DM * EFF * 2, (size_t)256 * EFF * 2, nullptr};
        EpiScale E{(const float*)(ws + WS_GATEE), (bf16_t*)(ws + WS_Y)};
        pg8::gemm_phase(F.lds, g, S, E);
        if (BOTH(10)) GRID_BAR();
    }
    if (IN(11)) { moe_sched_setup(F); p10_combine(F, args); }
#undef IN
#undef BOTH
}

extern "C" void kernel_launch(void* const* d_in, const int* in_sizes, int n_in, void* d_out, int out_size, void* d_ws, size_t ws_size, hipStream_t stream) {
    static int grid = 0;
    if (grid == 0) {
        if (n_in != 24 || in_sizes[0] != NTOK * DM || out_size != NTOK * DM || ws_size < WS_END) { fprintf(stderr, "kernel_launch: unexpected shapes (n_in %d, in0 %d, out %d, ws %zu)\n", n_in, n_in > 0 ? in_sizes[0] : -1, out_size, ws_size); grid = -1; return; }
        int dev = 0, cus = 0, per_cu = 0;
        if (hipGetDevice(&dev) != hipSuccess || hipDeviceGetAttribute(&cus, hipDeviceAttributeMultiprocessorCount, dev) != hipSuccess) { grid = -1; return; }
        if (hipFuncSetAttribute((const void*)fwd_kernel, hipFuncAttributeMaxDynamicSharedMemorySize, LDS_BYTES) != hipSuccess) { fprintf(stderr, "kernel_launch: hipFuncSetAttribute failed\n"); grid = -1; return; }
        if (hipOccupancyMaxActiveBlocksPerMultiprocessor(&per_cu, (const void*)fwd_kernel, NWAVES * 64, LDS_BYTES) != hipSuccess || per_cu < 1) { fprintf(stderr, "kernel_launch: occupancy query says %d\n", per_cu); per_cu = 1; }
        (void)hipGetLastError();
        grid = cus;
        if (grid > 256) grid = 256;
    }
    if (grid < 0) return;
    (void)hipMemsetAsync((char*)d_ws + WS_CTL, 0, CTL_BYTES, stream);
    Args a{};
    for (int i = 0; i < 24; ++i) a.in[i] = d_in[i];
    a.out = (float*)d_out; a.ws = (unsigned char*)d_ws;
    if (MK_N_LAUNCHES == 1) { a.ph_lo = 0; a.ph_hi = N_PHASES; hipLaunchKernelGGL(fwd_kernel, dim3(grid), dim3(NWAVES * 64), LDS_BYTES, stream, a); }
    else for (int p = 0; p < N_PHASES; ++p) { a.ph_lo = p; a.ph_hi = p + 1; hipLaunchKernelGGL(fwd_kernel, dim3(grid), dim3(NWAVES * 64), LDS_BYTES, stream, a); }
}
```
